# Optimizing an MI355X kernel written in HIP

```python
import math
import jax, jax.numpy as jnp
from jax import lax
import numpy as np

D_MODEL = 1024
BATCH = 16
SEQ = 256
DEPTH = 4
DEC_BATCH = 4
DEC_SEQ = 4096
PAST_LEN = 256

GRID_W = 64
H_A = 4
DK_A = 64
DV_A = 128
H_B = 4
DK_B = 64
DV_B = 128
H_C = 4
DK_C = 128
DV_C = 128
W_A = H_A * DV_A
W_B = H_B * DV_B
W_C = H_C * DV_C
N_DIR = 2
CONV_K = 5
CHUNK = 64
Q_BLOCK = 128
ROPE_BASE = 10000.0
EPS = 1e-6
IN_WIDTHS = (H_A * 2 * DK_A, H_A * 2 * DK_A, W_A, W_A,
             H_B * DK_B, H_B * DK_B, W_B, W_B,
             H_C * DK_C, H_C * DK_C, W_C, W_C, N_DIR * H_C, N_DIR * H_C,
             3 * D_MODEL)
D_IN = sum(IN_WIDTHS)

kernel_name = 'hybrid_diff_ret_gdn_dit_step'


def rms_norm(x, w):
    xf = x.astype(jnp.float32)
    y = xf * lax.rsqrt(jnp.mean(xf * xf, axis=-1, keepdims=True) + EPS)
    return (y * w.astype(jnp.float32)).astype(x.dtype)


def l2_norm(x):
    xf = x.astype(jnp.float32)
    return (xf * lax.rsqrt(jnp.sum(xf * xf, axis=-1, keepdims=True) + EPS)).astype(x.dtype)


def axial_rope_tables(n_tokens, dim, dtype):
    n_rows = n_tokens // GRID_W
    row = jnp.repeat(jnp.arange(n_rows, dtype=jnp.float32), GRID_W)
    col = jnp.tile(jnp.arange(GRID_W, dtype=jnp.float32), n_rows)
    n_freq = dim // 4
    inv = 1.0 / (ROPE_BASE ** (jnp.arange(n_freq, dtype=jnp.float32) / n_freq))
    ar = row[:, None] * inv
    ac = col[:, None] * inv
    ang = jnp.concatenate([ar, ar, ac, ac], axis=-1)
    return jnp.cos(ang).astype(dtype), jnp.sin(ang).astype(dtype)


def apply_axial_rope(x, cos, sin):
    extra = x.ndim - 3
    c = cos.reshape(cos.shape[:1] + (1,) * extra + cos.shape[1:])
    s = sin.reshape(sin.shape[:1] + (1,) * extra + sin.shape[1:])
    d = x.shape[-1]
    xs = x.reshape(x.shape[:-1] + (2, 2, d // 4))
    rot = jnp.stack([-xs[..., 1, :], xs[..., 0, :]], axis=-2).reshape(x.shape)
    return x * c + rot * s


def depthwise_conv(x, w):
    k, ch = w.shape
    return lax.conv_general_dilated(x, w[:, None, :].astype(x.dtype), (1,), ((k // 2, k // 2),),
                                    dimension_numbers=('NWC', 'WIO', 'NWC'), feature_group_count=ch)


def diff_attention(q, k, v, lam):
    b, t, h, _, d = q.shape
    dv = v.shape[-1]
    nb = t // Q_BLOCK
    qb = jnp.moveaxis(q.reshape(b, nb, Q_BLOCK, h, 2, d), 1, 0)
    scale = d ** -0.5

    def one_block(qi):
        s = jnp.einsum('bqhmd,bshmd->bmhqs', qi, k).astype(jnp.float32) * scale
        p = jax.nn.softmax(s, axis=-1)
        wts = (p[:, 0] - lam * p[:, 1]).astype(v.dtype)
        return jnp.einsum('bhqs,bshe->bqhe', wts, v)

    o = lax.map(one_block, qb)
    return jnp.moveaxis(o, 0, 1).reshape(b, t, h, dv)


def _to_chunks(a):
    b, t = a.shape[:2]
    a = a.reshape((b, t // CHUNK, CHUNK) + a.shape[2:]).astype(jnp.float32)
    return jnp.moveaxis(a, (1, 3), (0, 2))


def _from_chunks(o):
    o = jnp.moveaxis(o, (0, 2), (1, 3))
    return o.reshape((o.shape[0], o.shape[1] * o.shape[2]) + o.shape[3:])


def retention_scan(q, k, v, log_gamma, s0):
    dk = q.shape[-1]
    qc = _to_chunks(q)
    kc = _to_chunks(k) * dk ** -0.5
    vc = _to_chunks(v)
    i = jnp.arange(CHUNK, dtype=jnp.float32)
    rel = i[:, None] - i[None, :]
    causal = rel >= 0
    dmat = jnp.where(causal, jnp.exp(jnp.where(causal, rel, 0.0)[None] * log_gamma[:, None, None]), 0.0)
    q_dec = jnp.exp((i + 1.0)[None] * log_gamma[:, None])
    k_dec = jnp.exp((CHUNK - 1.0 - i)[None] * log_gamma[:, None])
    c_dec = jnp.exp(CHUNK * log_gamma)

    def step(s, inp):
        q_i, k_i, v_i = inp
        intra = jnp.einsum('bhid,bhjd->bhij', q_i, k_i) * dmat
        o = (jnp.einsum('bhij,bhje->bhie', intra, v_i)
             + jnp.einsum('bhid,bhde->bhie', q_i, s) * q_dec[:, :, None])
        s = s * c_dec[:, None, None] + jnp.einsum('bhjd,bhje->bhde', k_i * k_dec[:, :, None], v_i)
        return s, o

    s, o = lax.scan(step, s0.astype(jnp.float32), (qc, kc, vc))
    return _from_chunks(o), s


def gated_delta_scan(q, k, v, g, beta, s0):
    dk = q.shape[-1]
    qc = _to_chunks(q) * dk ** -0.5
    kc = _to_chunks(k)
    vc = _to_chunks(v)
    gc = jnp.cumsum(_to_chunks(g), axis=-1)
    bc = _to_chunks(beta)[..., None]
    kb = kc * bc
    lower = jnp.tril(jnp.ones((CHUNK, CHUNK), dtype=bool))
    strict = jnp.tril(jnp.ones((CHUNK, CHUNK), dtype=jnp.float32), -1)
    decay = jnp.exp(jnp.where(lower, gc[..., :, None] - gc[..., None, :], -jnp.inf))
    a = jnp.einsum('nbhid,nbhjd->nbhij', kb, kc) * decay * strict
    eye = jnp.eye(CHUNK, dtype=jnp.float32)
    t_inv = lax.linalg.triangular_solve(a + eye, jnp.broadcast_to(eye, a.shape), left_side=True,
                                        lower=True, unit_diagonal=True)
    u = jnp.einsum('nbhij,nbhjd->nbhid', t_inv, vc * bc)
    w = jnp.einsum('nbhij,nbhjd->nbhid', t_inv, kb * jnp.exp(gc)[..., None])
    qk = jnp.einsum('nbhid,nbhjd->nbhij', qc, kc) * decay

    def step(s, inp):
        q_i, k_i, u_i, w_i, g_i, qk_i = inp
        v_new = u_i - jnp.einsum('bhcd,bhde->bhce', w_i, s)
        o = (jnp.einsum('bhcd,bhde->bhce', q_i * jnp.exp(g_i)[..., None], s)
             + jnp.einsum('bhij,bhje->bhie', qk_i, v_new))
        g_last = g_i[..., -1:]
        s = s * jnp.exp(g_last)[..., None] + jnp.einsum(
            'bhcd,bhce->bhde', k_i * jnp.exp(g_last - g_i)[..., None], v_new)
        return s, o

    s, o = lax.scan(step, s0.astype(jnp.float32), (qc, kc, u, w, gc, qk))
    return _from_chunks(o), s


def trunk_layer(x, mod, layer_idx, p, rope, ctx):
    b, t, _ = x.shape
    f32 = jnp.float32
    shift, scale, gate = jnp.split(mod, 3, axis=-1)
    h = rms_norm(x, p['norm_w']) * (1.0 + scale) + shift
    proj = h @ p['w_in']
    split_pts = np.cumsum(IN_WIDTHS)[:-1].tolist()
    (aq, ak, av, az, bq, bk, bv, bz, cq, ck, cv, cz, c_beta, c_alpha, merge_logits) = jnp.split(proj, split_pts, axis=-1)

    lam_init = 0.8 - 0.6 * math.exp(-0.3 * layer_idx)
    qa = rms_norm(aq.reshape(b, t, H_A, 2, DK_A), p['qk_norm_w'][0])
    ka = rms_norm(ak.reshape(b, t, H_A, 2, DK_A), p['qk_norm_w'][1])
    va = av.reshape(b, t, H_A, DV_A)
    if rope is not None:
        qa = apply_axial_rope(qa, rope[0], rope[1])
        ka_att = apply_axial_rope(ka, rope[0], rope[1])
    else:
        ka_att = ka
    lv = p['diff_lambda'].astype(f32)
    lam = jnp.exp(jnp.sum(lv[0] * lv[1])) - jnp.exp(jnp.sum(lv[2] * lv[3])) + lam_init
    if ctx is None:
        k_all, v_all = ka_att, va
    else:
        k_all = jnp.concatenate([ka_att, ctx[0].astype(ka_att.dtype)], axis=1)
        v_all = jnp.concatenate([va, ctx[1].astype(va.dtype)], axis=1)
    oa = rms_norm(diff_attention(qa, k_all, v_all, lam), p['subln_w']) * (1.0 - lam_init)
    ya = (oa.reshape(b, t, W_A) * jax.nn.silu(az)) @ p['w_branch'][0]

    qr = bq.reshape(b, t, H_B, DK_B)
    kr = bk.reshape(b, t, H_B, DK_B)
    vr = bv.reshape(b, t, H_B, DV_B)
    if rope is not None:
        qr = apply_axial_rope(qr, rope[0], rope[1])
        kr = apply_axial_rope(kr, rope[0], rope[1])
    log_gamma = jax.nn.log_sigmoid(p['ret_decay'].astype(f32))
    s_ret = jnp.zeros((b, N_DIR, H_B, DK_B, DV_B), f32) if ctx is None else ctx[2]
    or_f, sr_f = retention_scan(qr, kr, vr, log_gamma[0], s_ret[:, 0])
    or_b, sr_b = retention_scan(jnp.flip(qr, 1), jnp.flip(kr, 1), jnp.flip(vr, 1), log_gamma[1], s_ret[:, 1])
    orr = rms_norm((or_f + jnp.flip(or_b, 1)).astype(x.dtype), p['ret_norm_w'])
    yb = (orr.reshape(b, t, W_B) * jax.nn.silu(bz)) @ p['w_branch'][1]

    qkv = jax.nn.silu(depthwise_conv(jnp.concatenate([cq, ck, cv], axis=-1), p['conv_w']))
    cq, ck, cv = jnp.split(qkv, [H_C * DK_C, 2 * H_C * DK_C], axis=-1)
    qd = l2_norm(cq.reshape(b, t, H_C, DK_C))
    kd = l2_norm(ck.reshape(b, t, H_C, DK_C))
    vd = cv.reshape(b, t, H_C, DV_C)
    beta = jax.nn.sigmoid(c_beta.reshape(b, t, N_DIR, H_C).astype(f32))
    g = -jnp.exp(p['gdn_a_log'].astype(f32)) * jax.nn.softplus(
        c_alpha.reshape(b, t, N_DIR, H_C).astype(f32) + p['gdn_dt_bias'].astype(f32))
    s_gdn = jnp.zeros((b, N_DIR, H_C, DK_C, DV_C), f32) if ctx is None else ctx[3]
    od_f, sd_f = gated_delta_scan(qd, kd, vd, g[:, :, 0], beta[:, :, 0], s_gdn[:, 0])
    od_b, sd_b = gated_delta_scan(jnp.flip(qd, 1), jnp.flip(kd, 1), jnp.flip(vd, 1),
                                  jnp.flip(g[:, :, 1], 1), jnp.flip(beta[:, :, 1], 1), s_gdn[:, 1])
    od = rms_norm((od_f + jnp.flip(od_b, 1)).astype(x.dtype), p['gdn_norm_w'])
    yc = (od.reshape(b, t, W_C) * jax.nn.silu(cz)) @ p['w_branch'][2]

    g_a, g_b, g_c = jnp.split(jax.nn.sigmoid(merge_logits), 3, axis=-1)
    y = (g_a * ya + g_b * yb + g_c * yc) @ p['w_out']
    x = x + gate * y
    if ctx is None:
        return x, (ka, va, jnp.stack([sr_f, sr_b], axis=1).astype(x.dtype),
                   jnp.stack([sd_f, sd_b], axis=1).astype(x.dtype))
    return x, None


def setup_inputs(seed: int = 0) -> dict:
    key = jax.random.key(seed)
    ks = jax.random.split(key, 24)
    f32 = jnp.float32

    def nrm(k, shape, s):
        return s * jax.random.normal(k, shape, f32)

    ret_base = 1.0 - 2.0 ** (-5.0 - jnp.arange(H_B, dtype=f32))
    ret_logit = jnp.log(ret_base) - jnp.log1p(-ret_base)
    dt = jnp.exp(jax.random.uniform(ks[20], (DEPTH, N_DIR, H_C), f32, math.log(1e-3), math.log(1e-1)))
    return {
        'x_prompt': nrm(ks[0], (BATCH, SEQ, D_MODEL), 1.0),
        'x_sample': nrm(ks[1], (DEC_BATCH, DEC_SEQ, D_MODEL), 1.0),
        'cache_attn_k': nrm(ks[2], (DEC_BATCH, DEPTH, PAST_LEN, H_A, 2, DK_A), 1.0),
        'cache_attn_v': nrm(ks[3], (DEC_BATCH, DEPTH, PAST_LEN, H_A, DV_A), 1.0),
        'state_ret': nrm(ks[4], (DEC_BATCH, DEPTH, N_DIR, H_B, DK_B, DV_B), 1.0),
        'state_gdn': nrm(ks[5], (DEC_BATCH, DEPTH, N_DIR, H_C, DK_C, DV_C), 0.1),
        'c': nrm(ks[6], (DEC_BATCH, D_MODEL), 1.0),
        'c_ctx': nrm(ks[7], (D_MODEL,), 1.0),
        'norm_w': 1.0 + nrm(ks[8], (DEPTH, D_MODEL), 0.02),
        'w_ada': nrm(ks[9], (DEPTH, D_MODEL, 3 * D_MODEL), 0.5 * D_MODEL ** -0.5),
        'b_ada': nrm(ks[10], (DEPTH, 3 * D_MODEL), 0.01),
        'w_in': nrm(ks[11], (DEPTH, D_MODEL, D_IN), D_MODEL ** -0.5),
        'qk_norm_w': 1.0 + nrm(ks[12], (DEPTH, 2, DK_A), 0.02),
        'diff_lambda': nrm(ks[13], (DEPTH, 4, DK_A), 0.1),
        'subln_w': 1.0 + nrm(ks[14], (DEPTH, DV_A), 0.02),
        'ret_decay': ret_logit + nrm(ks[15], (DEPTH, N_DIR, H_B), 0.1),
        'ret_norm_w': 1.0 + nrm(ks[16], (DEPTH, DV_B), 0.02),
        'conv_w': nrm(ks[17], (DEPTH, CONV_K, 3 * W_C), CONV_K ** -0.5),
        'gdn_a_log': jnp.log(jax.random.uniform(ks[18], (DEPTH, N_DIR, H_C), f32, 1.0, 16.0)),
        'gdn_dt_bias': dt + jnp.log(-jnp.expm1(-dt)),
        'gdn_norm_w': 1.0 + nrm(ks[19], (DEPTH, DV_C), 0.02),
        'w_branch': nrm(ks[21], (DEPTH, 3, W_A, D_MODEL), W_A ** -0.5),
        'w_out': nrm(ks[22], (DEPTH, D_MODEL, D_MODEL), D_MODEL ** -0.5),
    }


def reference(x_prompt, x_sample, cache_attn_k, cache_attn_v, state_ret, state_gdn, c, c_ctx,
              norm_w, w_ada, b_ada, w_in, qk_norm_w, diff_lambda, subln_w, ret_decay, ret_norm_w,
              conv_w, gdn_a_log, gdn_dt_bias, gdn_norm_w, w_branch, w_out):
    ctx_cond = jax.nn.silu(c_ctx)
    lat_cond = jax.nn.silu(c)
    cos, sin = axial_rope_tables(x_sample.shape[1], DK_A, x_sample.dtype)
    y_p, y_s = x_prompt, x_sample
    ks_out, vs_out, rs_out, gs_out = [], [], [], []
    for l in range(DEPTH):
        p = {'norm_w': norm_w[l], 'w_in': w_in[l], 'qk_norm_w': qk_norm_w[l],
             'diff_lambda': diff_lambda[l], 'subln_w': subln_w[l], 'ret_decay': ret_decay[l],
             'ret_norm_w': ret_norm_w[l], 'conv_w': conv_w[l], 'gdn_a_log': gdn_a_log[l],
             'gdn_dt_bias': gdn_dt_bias[l], 'gdn_norm_w': gdn_norm_w[l],
             'w_branch': w_branch[l], 'w_out': w_out[l]}
        m_ctx = (ctx_cond @ w_ada[l] + b_ada[l])[None, None, :]
        m_lat = (lat_cond @ w_ada[l] + b_ada[l])[:, None, :]
        y_p, (k_l, v_l, r_l, g_l) = trunk_layer(y_p, m_ctx, l, p, None, None)
        y_s, _ = trunk_layer(y_s, m_lat, l, p, (cos, sin),
                             (cache_attn_k[:, l], cache_attn_v[:, l], state_ret[:, l], state_gdn[:, l]))
        ks_out.append(k_l)
        vs_out.append(v_l)
        rs_out.append(r_l)
        gs_out.append(g_l)
    return (y_p, y_s, jnp.stack(ks_out, axis=1), jnp.stack(vs_out, axis=1),
            jnp.stack(rs_out, axis=1), jnp.stack(gs_out, axis=1))
```

```cpp
#include <hip/hip_runtime.h>
#include <hip/hip_cooperative_groups.h>
#include <stdint.h>
#include <cstdio>
namespace cg = cooperative_groups;

typedef unsigned short bf16;
typedef __attribute__((ext_vector_type(8))) short bf16x8;
typedef __attribute__((ext_vector_type(4))) float f32x4;
#define DEV __device__ __forceinline__

constexpr int M_TOT = 20480;
constexpr int M_CTX = 4096;
constexpr float EPS = 1e-6f;

constexpr size_t SZ512 = (size_t)M_TOT * 512 * 2;
constexpr size_t OFF_MOD = 0;
constexpr size_t OFF_CNT = OFF_MOD + 245760;
constexpr size_t OFF_CS = OFF_CNT + 256;
constexpr size_t OFF_WINT = OFF_CS + 8192;
constexpr size_t OFF_WBT = OFF_WINT + 18350080;
constexpr size_t OFF_WOT = OFF_WBT + 3145728;
constexpr size_t OFF_H = OFF_WOT + 2097152;
constexpr size_t OFF_QA = OFF_H + 41943040;
constexpr size_t OFF_KA = OFF_QA + SZ512;
constexpr size_t OFF_AZ = OFF_KA + SZ512;
constexpr size_t OFF_BQ = OFF_AZ + SZ512;
constexpr size_t OFF_BK = OFF_BQ + SZ512 / 2;
constexpr size_t OFF_BV = OFF_BK + SZ512 / 2;
constexpr size_t OFF_BZ = OFF_BV + SZ512;
constexpr size_t OFF_CQ = OFF_BZ + SZ512;
constexpr size_t OFF_CK = OFF_CQ + SZ512;
constexpr size_t OFF_CV = OFF_CK + SZ512;
constexpr size_t OFF_CZ = OFF_CV + SZ512;
constexpr size_t OFF_BA = OFF_CZ + SZ512;
constexpr size_t OFF_VTC = OFF_BA + 1310720;
constexpr size_t OFF_VTL = OFF_VTC + 4194304;
constexpr size_t OFF_KC = OFF_VTL + 17825792;
constexpr size_t OFF_CQ2 = OFF_KC + 1048576;
constexpr size_t OFF_CK2 = OFF_CQ2 + SZ512;
constexpr size_t OFF_U = OFF_CK2 + SZ512;
constexpr size_t OFF_W = OFF_U + 2 * SZ512;
constexpr size_t OFF_QKD = OFF_W + 2 * SZ512;
constexpr size_t OFF_GC = OFF_QKD + 20971520;
constexpr size_t OFF_RU = OFF_GC + 655360;
constexpr size_t OFF_BAR = OFF_RU + 41943040;
constexpr size_t WS_NEED = OFF_BAR + 16384;

constexpr size_t OUT_K = 20971520;
constexpr size_t OUT_V = 29360128;
constexpr size_t OUT_RET = 37748736;
constexpr size_t OUT_GDN = 41943040;

struct Params {
  const float* in[23];
  float* out;
  unsigned char* ws;
};

union U8 {
  uint4 u;
  bf16x8 v;
  uint2 h[2];
  uint32_t w[4];
};

typedef __bf16 bf16v2 __attribute__((ext_vector_type(2)));
DEV bf16 f2bf(float f) { return __builtin_bit_cast(unsigned short, (__bf16)f); }
DEV float bf2f(bf16 b) { return __uint_as_float(((uint32_t)b) << 16); }
DEV uint32_t pack2(float a, float b) { bf16v2 v; v[0] = (__bf16)a; v[1] = (__bf16)b; return __builtin_bit_cast(uint32_t, v); }
DEV float lo2f(uint32_t w) { return __uint_as_float(w << 16); }
DEV float hi2f(uint32_t w) { return __uint_as_float(w & 0xffff0000u); }
DEV float sigm(float x) { return __builtin_amdgcn_rcpf(1.f + __expf(-x)); }
DEV float silu(float x) { return x * __builtin_amdgcn_rcpf(1.f + __expf(-x)); }
DEV f32x4 mfma16(bf16x8 a, bf16x8 b, f32x4 c) { return __builtin_amdgcn_mfma_f32_16x16x32_bf16(a, b, c, 0, 0, 0); }
DEV int raw_tid() { int t = threadIdx.x; asm volatile("" : "+v"(t)); return t; }
DEV int opaque_tid() { return raw_tid() & 255; }
DEV int vhalf() { return __builtin_amdgcn_readfirstlane(raw_tid() >> 8); }
DEV float ex2(float x) { return __builtin_amdgcn_exp2f(x); }
DEV int vperm(int t) { return (t & ~31) + ((t >> 2) & 3) * 8 + ((t >> 4) & 1) * 4 + (t & 3); }
DEV f32x4 zero4() { f32x4 z = {0.f, 0.f, 0.f, 0.f}; return z; }

DEV void phase_mod(const Params& p, float* sm) {
  const int vbid = blockIdx.x * 2 + vhalf(), vnb = gridDim.x * 2;
  const int tid = opaque_tid();
  float* sc = sm;
  float* red = sm + 5120;
  const float* c = p.in[6];
  const float* cctx = p.in[7];
  for (int i = tid; i < 5120; i += 256) {
    int ci = i >> 10, k = i & 1023;
    float v = ci == 0 ? cctx[k] : c[(ci - 1) * 1024 + k];
    sc[i] = silu(v);
  }
  __syncthreads();
  float* mod = (float*)(p.ws + OFF_MOD);
  for (int item = vbid; item < 192; item += vnb) {
    int l = item / 48, jb = item % 48;
    int jj = tid & 63, kq = tid >> 6;
    const float* W = p.in[9] + (size_t)l * 1024 * 3072 + jb * 64 + jj;
    float a0 = 0, a1 = 0, a2 = 0, a3 = 0, a4 = 0;
    for (int k = kq * 256; k < kq * 256 + 256; k++) {
      float w = W[(size_t)k * 3072];
      a0 += sc[k] * w; a1 += sc[1024 + k] * w; a2 += sc[2048 + k] * w; a3 += sc[3072 + k] * w; a4 += sc[4096 + k] * w;
    }
    red[(kq * 5 + 0) * 64 + jj] = a0; red[(kq * 5 + 1) * 64 + jj] = a1; red[(kq * 5 + 2) * 64 + jj] = a2;
    red[(kq * 5 + 3) * 64 + jj] = a3; red[(kq * 5 + 4) * 64 + jj] = a4;
    __syncthreads();
    for (int o = tid; o < 320; o += 256) {
      int ci = o >> 6, j2 = o & 63;
      float s = red[(0 * 5 + ci) * 64 + j2] + red[(1 * 5 + ci) * 64 + j2] + red[(2 * 5 + ci) * 64 + j2] + red[(3 * 5 + ci) * 64 + j2];
      s += p.in[10][l * 3072 + jb * 64 + j2];
      mod[(l * 5 + ci) * 3072 + jb * 64 + j2] = s;
    }
    __syncthreads();
  }
  if (vbid == vnb - 1) {
    float2* cs = (float2*)(p.ws + OFF_CS);
    for (int i = tid; i < 1024; i += 256) {
      int pos = i >> 4, f = i & 15;
      float inv = 1.0f / powf(10000.0f, (float)f / 16.0f);
      float ang = (float)pos * inv;
      cs[i] = make_float2(cosf(ang), sinf(ang));
    }
  }
}

struct CvtT { const float* src; bf16* dst; int ld, k0, c0, nv, dld, r0; };
DEV CvtT cvt_params(const Params& p, int l, int id) {
  CvtT t;
  if (id < 2240) {
    int nt = id >> 4, kt = id & 15;
    int srccol0, nvalid;
    if (nt < 92) { srccol0 = nt * 64; nvalid = 5648 - nt * 64; if (nvalid > 64) nvalid = 64; if (nvalid < 0) nvalid = 0; if (nvalid == 0) srccol0 = 0; }
    else { srccol0 = 5648 + (nt - 92) * 64; nvalid = 64; }
    t.src = p.in[11] + (size_t)l * 1024 * 8720; t.ld = 8720; t.k0 = kt * 64; t.c0 = srccol0; t.nv = nvalid;
    t.dst = (bf16*)(p.ws + OFF_WINT); t.dld = 1024; t.r0 = nt * 64;
  } else if (id < 2624) {
    int q = id - 2240;
    int br = q >> 7, r = q & 127, nt = r >> 3, kt = r & 7;
    t.src = p.in[21] + (size_t)(l * 3 + br) * 512 * 1024; t.ld = 1024; t.k0 = kt * 64; t.c0 = nt * 64; t.nv = 64;
    t.dst = (bf16*)(p.ws + OFF_WBT) + (size_t)br * 1024 * 512; t.dld = 512; t.r0 = nt * 64;
  } else {
    int q = id - 2624;
    int nt = q >> 4, kt = q & 15;
    t.src = p.in[22] + (size_t)l * 1024 * 1024; t.ld = 1024; t.k0 = kt * 64; t.c0 = nt * 64; t.nv = 64;
    t.dst = (bf16*)(p.ws + OFF_WOT); t.dld = 1024; t.r0 = nt * 64;
  }
  return t;
}
DEV void cvt_load(const CvtT& t, float (&v)[16], int tid) {
  const int n = tid & 63, kk = tid >> 6;
#pragma unroll
  for (int i = 0; i < 16; i++) {
    const int k = i * 4 + kk;
    v[i] = (n < t.nv) ? t.src[(size_t)(t.k0 + k) * t.ld + t.c0 + n] : 0.f;
  }
}
DEV void cvt_store(const CvtT& t, const float (&v)[16], float* sm, int tid) {
  {
    const int n = tid & 63, kk = tid >> 6;
#pragma unroll
    for (int i = 0; i < 16; i++) sm[(i * 4 + kk) * 65 + n] = v[i];
  }
  __syncthreads();
  {
    int n = tid >> 2, kc = (tid & 3) * 16;
    U8 a, b;
#pragma unroll
    for (int i = 0; i < 4; i++) {
      a.w[i] = pack2(sm[(kc + 2 * i) * 65 + n], sm[(kc + 2 * i + 1) * 65 + n]);
      b.w[i] = pack2(sm[(kc + 8 + 2 * i) * 65 + n], sm[(kc + 8 + 2 * i + 1) * 65 + n]);
    }
    bf16* d = t.dst + (size_t)(t.r0 + n) * t.dld + t.k0 + kc;
    *(uint4*)d = a.u;
    *(uint4*)(d + 8) = b.u;
  }
  __syncthreads();
}

DEV void phase_cvt(const Params& p, int l, float* sm) {
  const int vbid = blockIdx.x * 2 + vhalf(), vnb = gridDim.x * 2;
  const int tid = opaque_tid();
  int id = vbid;
  if (id >= 2880) return;
  CvtT t = cvt_params(p, l, id);
  float v[16];
  cvt_load(t, v, tid);
  for (; id < 2880; id += vnb) {
    const int nid = id + vnb;
    const CvtT tn = cvt_params(p, l, nid < 2880 ? nid : id);
    float vn[16];
    cvt_load(tn, vn, tid);
    cvt_store(t, v, sm, tid);
    t = tn;
#pragma unroll
    for (int i = 0; i < 16; i++) v[i] = vn[i];
  }
}

DEV void phase_norm(const Params& p, int l) {
  const int vbid = blockIdx.x * 2 + vhalf(), vnb = gridDim.x * 2;
  const int tid = opaque_tid(), lane = tid & 63, wave = tid >> 6;
  const float* mod = (const float*)(p.ws + OFF_MOD);
  const float* nw = p.in[8] + l * 1024;
  bf16* H = (bf16*)(p.ws + OFF_H);
  const int gw = vbid * 4 + wave, nw_tot = vnb * 4;
  auto xrow = [&](int row) -> const float* {
    if (l == 0) return row < M_CTX ? p.in[0] + (size_t)row * 1024 : p.in[1] + (size_t)(row - M_CTX) * 1024;
    return p.out + (size_t)row * 1024;
  };
  float4 v[4];
  if (gw < M_TOT) {
    const float* x = xrow(gw);
#pragma unroll
    for (int i = 0; i < 4; i++) v[i] = *(const float4*)(x + i * 256 + lane * 4);
  }
  for (int row = gw; row < M_TOT; row += nw_tot) {
    float4 vn[4];
    const int nrow = row + nw_tot;
    if (nrow < M_TOT) {
      const float* xn = xrow(nrow);
#pragma unroll
      for (int i = 0; i < 4; i++) vn[i] = *(const float4*)(xn + i * 256 + lane * 4);
    } else {
#pragma unroll
      for (int i = 0; i < 4; i++) vn[i] = make_float4(0.f, 0.f, 0.f, 0.f);
    }
    int ci = row < M_CTX ? 0 : 1 + ((row - M_CTX) >> 12);
    const float* md = mod + (l * 5 + ci) * 3072;
    float ss = 0.f;
#pragma unroll
    for (int i = 0; i < 4; i++) ss += v[i].x * v[i].x + v[i].y * v[i].y + v[i].z * v[i].z + v[i].w * v[i].w;
#pragma unroll
    for (int o = 32; o >= 1; o >>= 1) ss += __shfl_xor(ss, o);
    float rstd = rsqrtf(ss * (1.f / 1024.f) + EPS);
#pragma unroll
    for (int i = 0; i < 4; i++) {
      int k = i * 256 + lane * 4;
      float4 w4 = *(const float4*)(nw + k);
      float4 sh = *(const float4*)(md + k);
      float4 sc = *(const float4*)(md + 1024 + k);
      float h0 = v[i].x * rstd * w4.x * (1.f + sc.x) + sh.x;
      float h1 = v[i].y * rstd * w4.y * (1.f + sc.y) + sh.y;
      float h2 = v[i].z * rstd * w4.z * (1.f + sc.z) + sh.z;
      float h3 = v[i].w * rstd * w4.w * (1.f + sc.w) + sh.w;
      uint2 o2 = make_uint2(pack2(h0, h1), pack2(h2, h3));
      *(uint2*)(H + (size_t)row * 1024 + k) = o2;
    }
#pragma unroll
    for (int i = 0; i < 4; i++) v[i] = vn[i];
  }
  bf16* KC = (bf16*)(p.ws + OFF_KC);
  bf16* VTL = (bf16*)(p.ws + OFF_VTL);
  const int gt = vbid * 256 + tid, nt = vnb * 256;
  for (int i = gt; i < 4 * 256 * 512; i += nt) {
    int b = i >> 17, s = (i >> 9) & 255, cc = i & 511;
    size_t src = ((size_t)(b * 4 + l) * 256 + s) * 512 + cc;
    KC[i] = f2bf(p.in[2][src]);
    int h = cc >> 7, dv = cc & 127;
    VTL[((size_t)(b * 4 + h) * 128 + dv) * 4352 + 4096 + vperm(s)] = f2bf(p.in[3][src]);
  }
}

DEV int lds_byte2(int r, int c) {
  int st = (r >> 4) * 2 + (c >> 5), ob = (r & 15) * 64 + (c & 31) * 2;
  return st * 1024 + (ob ^ (((ob >> 9) & 1) << 5));
}
DEV void stage_rc2(int b, int& R, int& C) {
  int st = b >> 10, sb = b & 1023, swz = sb ^ (((sb >> 9) & 1) << 5);
  R = (st >> 1) * 16 + swz / 64;
  C = (st & 1) * 32 + (swz % 64) / 2;
}
#define WAIT_V0() asm volatile("s_waitcnt vmcnt(0)" ::: "memory")

template <int NT>
DEV void gemm_stage(const bf16* __restrict__ A, const bf16* __restrict__ Bt, int kt, char* sa, char* sb,
                    const unsigned (&ao)[4], const unsigned (&bo)[4], int wave) {
#pragma unroll
  for (int i = 0; i < 4; i++)
    __builtin_amdgcn_global_load_lds((const unsigned*)((const char*)A + (ao[i] + (unsigned)kt * 128u)),
                                     (unsigned*)(sa + wave * 1024 + i * 8192), 16, 0, 0);
#pragma unroll
  for (int i = 0; i < NT; i++)
    __builtin_amdgcn_global_load_lds((const unsigned*)((const char*)Bt + (bo[i] + (unsigned)kt * 128u)),
                                     (unsigned*)(sb + wave * 1024 + i * 8192), 16, 0, 0);
  __builtin_amdgcn_sched_barrier(0);
}
template <int NT, bool SWAP>
DEV void gemm_compute(f32x4 (&acc)[8][NT], const char* sa, const char* sb, const int (&aoff)[2], const int (&boff)[2]) {
#pragma unroll
  for (int ks = 0; ks < 2; ks++) {
    bf16x8 af[8], bv[NT];
#pragma unroll
    for (int j = 0; j < NT; j++) bv[j] = *(const bf16x8*)(sb + boff[ks] + j * 2048);
#pragma unroll
    for (int i = 0; i < 8; i++) af[i] = *(const bf16x8*)(sa + aoff[ks] + i * 2048);
    __builtin_amdgcn_s_setprio(1);
#pragma unroll
    for (int i = 0; i < 8; i++)
#pragma unroll
      for (int j = 0; j < NT; j++) acc[i][j] = SWAP ? mfma16(bv[j], af[i], acc[i][j]) : mfma16(af[i], bv[j], acc[i][j]);
    __builtin_amdgcn_s_setprio(0);
  }
  __builtin_amdgcn_sched_group_barrier(0x100, 8 + NT, 0);
  __builtin_amdgcn_sched_group_barrier(0x008, 8 * NT, 0);
  __builtin_amdgcn_sched_group_barrier(0x100, 8 + NT, 0);
  __builtin_amdgcn_sched_group_barrier(0x008, 8 * NT, 0);
  __builtin_amdgcn_sched_barrier(0);
}
struct Lds4 { char* a0; char* b0; char* a1; char* b1; };
template <int NT, bool SWAP = false>
DEV void gemm_loop8(f32x4 (&acc)[8][NT], const bf16* __restrict__ A, int lda, const bf16* __restrict__ Bt, int ldb, int K,
                    const Lds4& L) {
  const int tid = raw_tid(), lane = tid & 63, l16 = lane & 15, quad = lane >> 4;
  const int wave = __builtin_amdgcn_readfirstlane(tid >> 6);
  const int wm = wave >> 2, wn = wave & 3;
  unsigned ao[4], bo[4];
#pragma unroll
  for (int i = 0; i < 4; i++) {
    int r, c;
    stage_rc2(wave * 1024 + i * 8192 + lane * 16, r, c);
    ao[i] = (unsigned)(r * lda + c) * 2u;
    bo[i] = (unsigned)(r * ldb + c) * 2u;
  }
  int aoff[2], boff[2];
#pragma unroll
  for (int ks = 0; ks < 2; ks++) {
    aoff[ks] = lds_byte2(wm * 128 + l16, ks * 32 + quad * 8);
    boff[ks] = lds_byte2(wn * NT * 16 + l16, ks * 32 + quad * 8);
  }
  const int nk = K >> 6;
  gemm_stage<NT>(A, Bt, 0, L.a0, L.b0, ao, bo, wave);
  WAIT_V0();
  __syncthreads();
  for (int kt = 0; kt < nk; kt += 2) {
    gemm_stage<NT>(A, Bt, kt + 1, L.a1, L.b1, ao, bo, wave);
    gemm_compute<NT, SWAP>(acc, L.a0, L.b0, aoff, boff);
    WAIT_V0();
    __syncthreads();
    if (kt + 2 < nk) gemm_stage<NT>(A, Bt, kt + 2, L.a0, L.b0, ao, bo, wave);
    gemm_compute<NT, SWAP>(acc, L.a1, L.b1, aoff, boff);
    WAIT_V0();
    __syncthreads();
  }
}

template <int NT>
DEV void zero_acc(f32x4 (&acc)[8][NT]) {
#pragma unroll
  for (int i = 0; i < 8; i++)
#pragma unroll
    for (int j = 0; j < NT; j++) acc[i][j] = zero4();
}

DEV int xcd_compact_bid() {
  const int b = (int)blockIdx.x, n = (int)gridDim.x;
  return ((n & 7) == 0) ? (b & 7) * (n >> 3) + (b >> 3) : b;
}
DEV void phase_proj(const Params& p, int l, const Lds4& L) {
  const int tid = raw_tid(), lane = tid & 63;
  int l16 = lane & 15, quad = lane >> 4;
  const int wave = __builtin_amdgcn_readfirstlane(tid >> 6);
  const int wm = wave >> 2, wn = wave & 3;
  const bf16* H = (const bf16*)(p.ws + OFF_H);
  const bf16* WT = (const bf16*)(p.ws + OFF_WINT);
  const float2* cs = (const float2*)(p.ws + OFF_CS);
  unsigned char* ws = p.ws;
  const int vbx = xcd_compact_bid();
  for (int tile = vbx; tile < 80 * 22; tile += gridDim.x) {
    const int mt = (tile / 88) * 4 + (tile & 3), nt = (tile % 88) >> 2;
    f32x4 acc[8][4];
    zero_acc<4>(acc);
    const int row0 = mt * 256 + wm * 128;
    const int cb = nt * 256 + wn * 64;
    const bool ctx = row0 < M_CTX;
    if (nt == 4 || nt == 5) {
      gemm_loop8<4, false>(acc, H + (size_t)mt * 256 * 1024, 1024, WT + (size_t)nt * 256 * 1024, 1024, 1024, L);
      asm volatile("" : "+v"(l16), "+v"(quad));
      const int c0 = cb - 1024, h = c0 >> 7, dv0 = c0 & 127;
#pragma unroll
      for (int i = 0; i < 8; i++) {
        const int tb = row0 + i * 16 + quad * 4;
#pragma unroll
        for (int j = 0; j < 4; j++) {
          const int dv = dv0 + j * 16 + l16;
          uint2 pk = make_uint2(pack2(acc[i][j][0], acc[i][j][1]), pack2(acc[i][j][2], acc[i][j][3]));
          if (ctx) {
            int b = tb >> 8, t = tb & 255;
            bf16* vt = (bf16*)(ws + OFF_VTC) + ((size_t)(b * 4 + h) * 128 + dv) * 256 + vperm(t);
            *(uint2*)vt = pk;
            float* o = p.out + OUT_V + ((size_t)(b * 4 + l) * 256 + t) * 512 + c0 + j * 16 + l16;
#pragma unroll
            for (int e = 0; e < 4; e++) o[(size_t)e * 512] = acc[i][j][e];
          } else {
            int r = tb - M_CTX, b = r >> 12, t = r & 4095;
            bf16* vt = (bf16*)(ws + OFF_VTL) + ((size_t)(b * 4 + h) * 128 + dv) * 4352 + vperm(t);
            *(uint2*)vt = pk;
          }
        }
      }
      continue;
    }
    gemm_loop8<4, true>(acc, H + (size_t)mt * 256 * 1024, 1024, WT + (size_t)nt * 256 * 1024, 1024, 1024, L);
    asm volatile("" : "+v"(l16), "+v"(quad));
    if (cb < 1024 || (cb >= 2048 && cb < 2560)) {
      const bool isA = cb < 1024;
      const bool isk = isA ? (cb >= 512) : (cb >= 2304);
      float4 wv[4];
#pragma unroll
      for (int j = 0; j < 4; j++) wv[j] = make_float4(1.f, 1.f, 1.f, 1.f);
      if (isA) {
        const float* qkw = p.in[12] + (l * 2 + (isk ? 1 : 0)) * 64 + quad * 4;
#pragma unroll
        for (int j = 0; j < 4; j++) wv[j] = *(const float4*)(qkw + j * 16);
      }
      bf16* dst;
      int dld, c0;
      if (isA) { dst = (bf16*)(ws + (isk ? OFF_KA : OFF_QA)); dld = 512; c0 = cb & 511; }
      else { dst = (bf16*)(ws + (isk ? OFF_BK : OFF_BQ)); dld = 256; c0 = (cb - 2048) & 255; }
      const float post = (isA && !isk) ? 0.18033688011112042f : ((!isA && isk) ? 0.125f : 1.f);
#pragma unroll
      for (int i = 0; i < 8; i++) {
        const int row = row0 + i * 16 + l16;
        float v[4][4];
#pragma unroll
        for (int j = 0; j < 4; j++)
#pragma unroll
          for (int e = 0; e < 4; e++) v[j][e] = acc[i][j][e];
        if (isA) {
          float ss = 0.f;
#pragma unroll
          for (int j = 0; j < 4; j++)
#pragma unroll
            for (int e = 0; e < 4; e++) ss += v[j][e] * v[j][e];
          ss += __shfl_xor(ss, 16);
          ss += __shfl_xor(ss, 32);
          const float rstd = rsqrtf(ss * (1.f / 64.f) + EPS);
#pragma unroll
          for (int j = 0; j < 4; j++) {
            v[j][0] *= rstd * wv[j].x; v[j][1] *= rstd * wv[j].y; v[j][2] *= rstd * wv[j].z; v[j][3] *= rstd * wv[j].w;
          }
          if (isk && ctx) {
            int b = row >> 8, t = row & 255;
            float* o = p.out + OUT_K + ((size_t)(b * 4 + l) * 256 + t) * 512 + c0 + quad * 4;
#pragma unroll
            for (int j = 0; j < 4; j++) *(float4*)(o + j * 16) = make_float4(v[j][0], v[j][1], v[j][2], v[j][3]);
          }
        }
        if (!ctx) {
          const int t = (row - M_CTX) & 4095;
          const float2* cr = cs + (t >> 6) * 16 + quad * 4;
          const float2* cc = cs + (t & 63) * 16 + quad * 4;
#pragma unroll
          for (int e = 0; e < 4; e++) {
            const float2 r2 = cr[e], c2 = cc[e];
            const float y0 = v[0][e] * r2.x - v[1][e] * r2.y, y1 = v[1][e] * r2.x + v[0][e] * r2.y;
            const float y2 = v[2][e] * c2.x - v[3][e] * c2.y, y3 = v[3][e] * c2.x + v[2][e] * c2.y;
            v[0][e] = y0; v[1][e] = y1; v[2][e] = y2; v[3][e] = y3;
          }
        }
        bf16* d = dst + (size_t)row * dld + c0 + quad * 4;
#pragma unroll
        for (int j = 0; j < 4; j++)
          *(uint2*)(d + j * 16) = make_uint2(pack2(v[j][0] * post, v[j][1] * post), pack2(v[j][2] * post, v[j][3] * post));
      }
    } else {
      bf16* dst; int c0; bool act = false;
      if (cb < 2048) { dst = (bf16*)(ws + OFF_AZ); c0 = cb - 1536; act = true; }
      else if (cb < 3072) { dst = (bf16*)(ws + OFF_BV); c0 = cb - 2560; }
      else if (cb < 3584) { dst = (bf16*)(ws + OFF_BZ); c0 = cb - 3072; act = true; }
      else if (cb < 4096) { dst = (bf16*)(ws + OFF_CQ); c0 = cb - 3584; }
      else if (cb < 4608) { dst = (bf16*)(ws + OFF_CK); c0 = cb - 4096; }
      else if (cb < 5120) { dst = (bf16*)(ws + OFF_CV); c0 = cb - 4608; }
      else { dst = (bf16*)(ws + OFF_CZ); c0 = cb - 5120; act = true; }
#pragma unroll
      for (int i = 0; i < 8; i++) {
        bf16* d = dst + (size_t)(row0 + i * 16 + l16) * 512 + c0 + quad * 4;
#pragma unroll
        for (int j = 0; j < 4; j++) {
          float v0 = acc[i][j][0], v1 = acc[i][j][1], v2 = acc[i][j][2], v3 = acc[i][j][3];
          if (act) { v0 = silu(v0); v1 = silu(v1); v2 = silu(v2); v3 = silu(v3); }
          *(uint2*)(d + j * 16) = make_uint2(pack2(v0, v1), pack2(v2, v3));
        }
      }
    }
  }
  const int nbk = (int)gridDim.x, firstb = nbk > 32 ? nbk - 32 : 0;
  if (vbx >= firstb) {
    for (int mt = vbx - firstb; mt < 80; mt += nbk - firstb) {
      f32x4 acc[8][1];
      zero_acc<1>(acc);
      gemm_loop8<1>(acc, H + (size_t)mt * 256 * 1024, 1024, WT + (size_t)5632 * 1024, 1024, 1024, L);
      asm volatile("" : "+v"(l16), "+v"(quad));
      if (wn == 0) {
        float* ba = (float*)(ws + OFF_BA);
        const int row0 = mt * 256 + wm * 128;
#pragma unroll
        for (int i = 0; i < 8; i++)
#pragma unroll
          for (int e = 0; e < 4; e++) ba[(size_t)(row0 + i * 16 + quad * 4 + e) * 16 + l16] = acc[i][0][e];
      }
    }
  }
}

DEV float log_sigmoid(float x) { return x < 0.f ? x - log1pf(expf(x)) : -log1pf(expf(-x)); }

DEV void ret_prep_item(const Params& p, int l, int item, bf16* sm) {
  const int tid = opaque_tid(), lane = tid & 63, wave = tid >> 6, l16 = lane & 15, quad = lane >> 4;
  const int c = item >> 2, h = item & 3;
  bf16* sKT0 = sm;
  bf16* sKT1 = sm + 4608;
  bf16* sVT = sm + 9216;
  const float lgf = log_sigmoid(p.in[15][l * 8 + h]);
  const float lgb = log_sigmoid(p.in[15][l * 8 + 4 + h]);
  const bf16* BK = (const bf16*)(p.ws + OFF_BK);
  const bf16* BV = (const bf16*)(p.ws + OFF_BV);
  const int r0 = c * 64;
  {
    int t = tid >> 2, dq = (tid & 3) * 16;
    float df = __expf(lgf * (float)(63 - t)), db = __expf(lgb * (float)t);
    const bf16* src = BK + (size_t)(r0 + t) * 256 + h * 64 + dq;
    U8 a, b;
    a.u = *(const uint4*)src; b.u = *(const uint4*)(src + 8);
#pragma unroll
    for (int i = 0; i < 4; i++) {
      float x0 = lo2f(a.w[i]), x1 = hi2f(a.w[i]), x2 = lo2f(b.w[i]), x3 = hi2f(b.w[i]);
      sKT0[(dq + 2 * i) * 72 + t] = f2bf(x0 * df); sKT0[(dq + 2 * i + 1) * 72 + t] = f2bf(x1 * df);
      sKT0[(dq + 8 + 2 * i) * 72 + t] = f2bf(x2 * df); sKT0[(dq + 8 + 2 * i + 1) * 72 + t] = f2bf(x3 * df);
      sKT1[(dq + 2 * i) * 72 + t] = f2bf(x0 * db); sKT1[(dq + 2 * i + 1) * 72 + t] = f2bf(x1 * db);
      sKT1[(dq + 8 + 2 * i) * 72 + t] = f2bf(x2 * db); sKT1[(dq + 8 + 2 * i + 1) * 72 + t] = f2bf(x3 * db);
    }
    int dvq = (tid & 3) * 32;
    const bf16* sv = BV + (size_t)(r0 + t) * 512 + h * 128 + dvq;
#pragma unroll
    for (int g = 0; g < 4; g++) {
      U8 x; x.u = *(const uint4*)(sv + g * 8);
#pragma unroll
      for (int i = 0; i < 4; i++) {
        sVT[(dvq + g * 8 + 2 * i) * 72 + t] = (bf16)(x.w[i] & 0xffffu);
        sVT[(dvq + g * 8 + 2 * i + 1) * 72 + t] = (bf16)(x.w[i] >> 16);
      }
    }
  }
  __syncthreads();
  {
    const int d = wave & 1, rt0 = (wave >> 1) * 2;
    const bf16* sKT = d ? sKT1 : sKT0;
    bf16* RU = (bf16*)(p.ws + OFF_RU) + ((size_t)(c * 4 + h) * 2 + d) * 8192;
#pragma unroll
    for (int ri = 0; ri < 2; ri++) {
      const int rt = rt0 + ri;
      bf16x8 a0 = *(const bf16x8*)(sKT + (rt * 16 + l16) * 72 + quad * 8);
      bf16x8 a1 = *(const bf16x8*)(sKT + (rt * 16 + l16) * 72 + 32 + quad * 8);
#pragma unroll
      for (int j = 0; j < 8; j++) {
        f32x4 acc = zero4();
        bf16x8 b0 = *(const bf16x8*)(sVT + (j * 16 + l16) * 72 + quad * 8);
        bf16x8 b1 = *(const bf16x8*)(sVT + (j * 16 + l16) * 72 + 32 + quad * 8);
        acc = mfma16(a0, b0, acc);
        acc = mfma16(a1, b1, acc);
        uint2 pk = make_uint2(pack2(acc[0], acc[1]), pack2(acc[2], acc[3]));
        *(uint2*)(RU + (j * 16 + l16) * 64 + rt * 16 + quad * 4) = pk;
      }
    }
  }
  __syncthreads();
}

DEV void ret_scan_item(const Params& p, int l, int item) {
  const int tid = opaque_tid();
  const int part = item & 3, chain = item >> 2;
  bool lat; int b, h, d;
  if (chain < 32) { lat = true; b = chain >> 3; h = (chain >> 1) & 3; d = chain & 1; }
  else { int cc = chain - 32; lat = false; b = cc >> 3; h = (cc >> 1) & 3; d = cc & 1; }
  const int N = lat ? 64 : 4;
  const int cbase = lat ? 64 + b * 64 : b * 4;
  const int idx = part * 2048 + tid * 8;
  const int dv = idx >> 6, dk0 = idx & 63;
  const float lg = log_sigmoid(p.in[15][l * 8 + d * 4 + h]);
  const float cdec = __expf(64.f * lg);
  float S[8];
  if (lat) {
    const float* s0 = p.in[4] + ((size_t)((b * 4 + l) * 2 + d) * 4 + h) * 8192;
#pragma unroll
    for (int i = 0; i < 8; i++) S[i] = s0[(dk0 + i) * 128 + dv];
  } else {
#pragma unroll
    for (int i = 0; i < 8; i++) S[i] = 0.f;
  }
  bf16* RU = (bf16*)(p.ws + OFF_RU);
  for (int n0 = 0; n0 < N; n0 += 4) {
    bf16* ptr[4];
    U8 u[4];
#pragma unroll
    for (int k = 0; k < 4; k++) {
      const int n = n0 + k;
      const int c = cbase + (d == 0 ? n : N - 1 - n);
      ptr[k] = RU + ((size_t)(c * 4 + h) * 2 + d) * 8192 + idx;
      u[k].u = *(const uint4*)ptr[k];
    }
#pragma unroll
    for (int k = 0; k < 4; k++) {
      U8 o;
#pragma unroll
      for (int i = 0; i < 4; i++) o.w[i] = pack2(S[2 * i], S[2 * i + 1]);
      *(uint4*)ptr[k] = o.u;
#pragma unroll
      for (int i = 0; i < 4; i++) {
        S[2 * i] = S[2 * i] * cdec + lo2f(u[k].w[i]);
        S[2 * i + 1] = S[2 * i + 1] * cdec + hi2f(u[k].w[i]);
      }
    }
  }
  if (!lat) {
    float* o = p.out + OUT_RET + ((size_t)((b * 4 + l) * 2 + d) * 4 + h) * 8192;
#pragma unroll
    for (int i = 0; i < 8; i++) o[(dk0 + i) * 128 + dv] = S[i];
  }
}

DEV void ret_post_item(const Params& p, int l, int item, bf16* sm, bf16* smB, int dry) {
  const int tid = opaque_tid(), lane = tid & 63, wave = tid >> 6, l16 = lane & 15, quad = lane >> 4;
  const int c = item >> 2, h = item & 3;
  bf16* sQ = sm;
  bf16* sWm = sm + 4608;
  bf16* sVT = sm + 9216;
  bf16* sK = sVT;
  bf16* sSf = smB;
  bf16* sSb = smB + 9216;
  const float lgf = log_sigmoid(p.in[15][l * 8 + h]);
  const float lgb = log_sigmoid(p.in[15][l * 8 + 4 + h]);
  const bf16* BQ = (const bf16*)(p.ws + OFF_BQ);
  const bf16* BK = (const bf16*)(p.ws + OFF_BK);
  bf16* BV = (bf16*)(p.ws + OFF_BV);
  const bf16* BZ = (const bf16*)(p.ws + OFF_BZ);
  const bf16* RU = (const bf16*)(p.ws + OFF_RU) + (size_t)(c * 4 + h) * 2 * 8192;
  const int r0 = c * 64;
  for (int ch = tid; ch < 1024; ch += 256) {
    int which = ch >> 9, cc = ch & 511, t = cc >> 3, k8 = (cc & 7) * 8;
    const bf16* src = (which ? BK : BQ) + (size_t)(r0 + t) * 256 + h * 64 + k8;
    *(uint4*)((which ? sK : sQ) + t * 72 + k8) = *(const uint4*)src;
  }
  for (int ch = tid; ch < 2048; ch += 256) {
    int which = ch >> 10, cc = ch & 1023, dv = cc >> 3, k8 = (cc & 7) * 8;
    *(uint4*)((which ? sSb : sSf) + dv * 72 + k8) = *(const uint4*)(RU + which * 8192 + dv * 64 + k8);
  }
  __syncthreads();
  {
    bf16x8 a0 = *(const bf16x8*)(sQ + (wave * 16 + l16) * 72 + quad * 8);
    bf16x8 a1 = *(const bf16x8*)(sQ + (wave * 16 + l16) * 72 + 32 + quad * 8);
    f32x4 qk[4];
#pragma unroll
    for (int j = 0; j < 4; j++) {
      qk[j] = zero4();
      bf16x8 b0 = *(const bf16x8*)(sK + (j * 16 + l16) * 72 + quad * 8);
      bf16x8 b1 = *(const bf16x8*)(sK + (j * 16 + l16) * 72 + 32 + quad * 8);
      qk[j] = mfma16(a0, b0, qk[j]);
      qk[j] = mfma16(a1, b1, qk[j]);
    }
#pragma unroll
    for (int j = 0; j < 4; j++)
#pragma unroll
      for (int e = 0; e < 4; e++) {
        int t = wave * 16 + quad * 4 + e, t2 = j * 16 + l16;
        float f = 0.f;
        if (t >= t2) f += __expf(lgf * (float)(t - t2));
        if (t2 >= t) f += __expf(lgb * (float)(t2 - t));
        sWm[t * 72 + t2] = f2bf(qk[j][e] * f);
      }
  }
  __syncthreads();
  {
    int t = tid >> 2, dvq = (tid & 3) * 32;
    const bf16* sv = BV + (size_t)(r0 + t) * 512 + h * 128 + dvq;
#pragma unroll
    for (int g = 0; g < 4; g++) {
      U8 x; x.u = *(const uint4*)(sv + g * 8);
#pragma unroll
      for (int i = 0; i < 4; i++) {
        sVT[(dvq + g * 8 + 2 * i) * 72 + t] = (bf16)(x.w[i] & 0xffffu);
        sVT[(dvq + g * 8 + 2 * i + 1) * 72 + t] = (bf16)(x.w[i] >> 16);
      }
    }
  }
  __syncthreads();
  {
    bf16x8 aw0 = *(const bf16x8*)(sWm + (wave * 16 + l16) * 72 + quad * 8);
    bf16x8 aw1 = *(const bf16x8*)(sWm + (wave * 16 + l16) * 72 + 32 + quad * 8);
    bf16x8 aq0 = *(const bf16x8*)(sQ + (wave * 16 + l16) * 72 + quad * 8);
    bf16x8 aq1 = *(const bf16x8*)(sQ + (wave * 16 + l16) * 72 + 32 + quad * 8);
    float rf[4], rb[4];
#pragma unroll
    for (int e = 0; e < 4; e++) {
      int t = wave * 16 + quad * 4 + e;
      rf[e] = __expf(lgf * (float)(t + 1));
      rb[e] = __expf(lgb * (float)(64 - t));
    }
    f32x4 o[8];
    float ss[4] = {0.f, 0.f, 0.f, 0.f};
#pragma unroll
    for (int j = 0; j < 8; j++) {
      const int bo = (j * 16 + l16) * 72 + quad * 8;
      f32x4 a1 = zero4(), a2 = zero4(), a3 = zero4();
      a1 = mfma16(aw0, *(const bf16x8*)(sVT + bo), a1);
      a1 = mfma16(aw1, *(const bf16x8*)(sVT + bo + 32), a1);
      a2 = mfma16(aq0, *(const bf16x8*)(sSf + bo), a2);
      a2 = mfma16(aq1, *(const bf16x8*)(sSf + bo + 32), a2);
      a3 = mfma16(aq0, *(const bf16x8*)(sSb + bo), a3);
      a3 = mfma16(aq1, *(const bf16x8*)(sSb + bo + 32), a3);
#pragma unroll
      for (int e = 0; e < 4; e++) {
        float v = a1[e] + rf[e] * a2[e] + rb[e] * a3[e];
        o[j][e] = v;
        ss[e] += v * v;
      }
    }
#pragma unroll
    for (int e = 0; e < 4; e++) {
      float s = ss[e];
      s += __shfl_xor(s, 1); s += __shfl_xor(s, 2); s += __shfl_xor(s, 4); s += __shfl_xor(s, 8);
      ss[e] = rsqrtf(s * (1.f / 128.f) + EPS);
    }
    const float* nw = p.in[16] + l * 128;
#pragma unroll
    for (int j = 0; j < 8; j++) {
      float w = nw[j * 16 + l16];
#pragma unroll
      for (int e = 0; e < 4; e++) {
        int row = r0 + wave * 16 + quad * 4 + e;
        size_t off = (size_t)row * 512 + h * 128 + j * 16 + l16;
        float z = bf2f(BZ[off]);
        if (!dry) BV[off] = f2bf(o[j][e] * ss[e] * w * z);
      }
    }
  }
  __syncthreads();
}

template <bool UPPER>
DEV void solve_tri(float* T, int lane) {
#pragma unroll 1
  for (int blk = 0; blk < 8; blk++) {
    float t[64];
#pragma unroll
    for (int j = 0; j < 64; j++) t[j] = T[j * 68 + lane];
    float tb[8], v[8];
#pragma unroll
    for (int jj = 0; jj < 8; jj++) {
      const int j = UPPER ? 63 - (blk * 8 + jj) : blk * 8 + jj;
      tb[jj] = T[j * 68 + lane];
    }
#pragma unroll
    for (int rr = 0; rr < 8; rr++) {
      const int r = UPPER ? 63 - (blk * 8 + rr) : blk * 8 + rr;
      float4 a[16];
#pragma unroll
      for (int q = 0; q < 16; q++) a[q] = *(const float4*)(T + r * 68 + q * 4);
      float s0 = 0.f, s1 = 0.f, s2 = 0.f, s3 = 0.f;
#pragma unroll
      for (int q = 0; q < 16; q++) {
        s0 = fmaf(a[q].x, t[4 * q + 0], s0);
        s1 = fmaf(a[q].y, t[4 * q + 1], s1);
        s2 = fmaf(a[q].z, t[4 * q + 2], s2);
        s3 = fmaf(a[q].w, t[4 * q + 3], s3);
      }
      float s = (s0 + s1) + (s2 + s3);
#pragma unroll
      for (int jj = 0; jj < rr; jj++) {
        const int j = UPPER ? 63 - (blk * 8 + jj) : blk * 8 + jj;
        s = fmaf(T[r * 68 + j], v[jj] - tb[jj], s);
      }
      v[rr] = (r == lane ? 1.f : 0.f) - s;
    }
    __builtin_amdgcn_wave_barrier();
#pragma unroll
    for (int rr = 0; rr < 8; rr++) {
      const int r = UPPER ? 63 - (blk * 8 + rr) : blk * 8 + rr;
      T[r * 68 + lane] = v[rr];
    }
    __builtin_amdgcn_wave_barrier();
  }
}

DEV void gdn_prep_item(const Params& p, int l, int item, bf16* sm, bf16* smB) {
  const int tid = opaque_tid(), lane = tid & 63, wave = tid >> 6, l16 = lane & 15, quad = lane >> 4;
  const int c = item >> 2, h = item & 3;
  bf16* sQ = sm;
  bf16* sK = sm + 8704;
  bf16* sKT = smB;
  bf16* sVT = smB + 9216;
  float* sBeta = (float*)(sm + 17408);
  float* sGc = sBeta + 128;
  float* T0 = (float*)sQ;
  float* T1 = (float*)sK;
  const int r0 = c * 64;
  int seq_lo, seq_hi;
  if (c < 64) { seq_lo = (c >> 2) * 256; seq_hi = seq_lo + 256; }
  else { seq_lo = M_CTX + ((c - 64) >> 6) * 4096; seq_hi = seq_lo + 4096; }
  {
    const int cc = tid & 15, rg = tid >> 4;
    const int gr = r0 + rg * 4;
    bf16* CQ2 = (bf16*)(p.ws + OFF_CQ2);
    bf16* CK2 = (bf16*)(p.ws + OFF_CK2);
    typedef unsigned int u32x4 __attribute__((ext_vector_type(4)));
    u32x4 xp[8];
    auto conv_load = [&](int seg) __attribute__((always_inline)) {
      const bf16* src = (const bf16*)(p.ws + (seg == 0 ? OFF_CQ : (seg == 1 ? OFF_CK : OFF_CV))) + h * 128 + cc * 8;
#pragma unroll
      for (int r = 0; r < 8; r++) {
        const int rr = gr + r - 2;
        const u32x4 zz = {0u, 0u, 0u, 0u};
        xp[r] = (rr >= seq_lo && rr < seq_hi) ? *(const u32x4*)(src + (size_t)rr * 512) : zz;
      }
    };
    conv_load(0);
#pragma unroll 1
    for (int seg = 0; seg < 3; seg++) {
      const float* cw = p.in[17] + (size_t)l * 5 * 1536 + seg * 512 + h * 128 + cc * 8;
      U8 x[8];
#pragma unroll
      for (int r = 0; r < 8; r++) { x[r].w[0] = xp[r][0]; x[r].w[1] = xp[r][1]; x[r].w[2] = xp[r][2]; x[r].w[3] = xp[r][3]; }
      conv_load(seg < 2 ? seg + 1 : 2);
      float o[4][8];
#pragma unroll
      for (int r = 0; r < 4; r++)
#pragma unroll
        for (int i = 0; i < 8; i++) o[r][i] = 0.f;
#pragma unroll
      for (int j = 0; j < 5; j++) {
        const float4 w0 = *(const float4*)(cw + j * 1536), w1 = *(const float4*)(cw + j * 1536 + 4);
#pragma unroll
        for (int r = 0; r < 4; r++) {
          o[r][0] += lo2f(x[r + j].w[0]) * w0.x; o[r][1] += hi2f(x[r + j].w[0]) * w0.y;
          o[r][2] += lo2f(x[r + j].w[1]) * w0.z; o[r][3] += hi2f(x[r + j].w[1]) * w0.w;
          o[r][4] += lo2f(x[r + j].w[2]) * w1.x; o[r][5] += hi2f(x[r + j].w[2]) * w1.y;
          o[r][6] += lo2f(x[r + j].w[3]) * w1.z; o[r][7] += hi2f(x[r + j].w[3]) * w1.w;
        }
      }
      U8 pk[4];
#pragma unroll
      for (int r = 0; r < 4; r++) {
        float ss = 0.f;
#pragma unroll
        for (int i = 0; i < 8; i++) { o[r][i] = silu(o[r][i]); ss += o[r][i] * o[r][i]; }
        float rn = 1.f;
        if (seg < 2) {
          ss += __shfl_xor(ss, 1); ss += __shfl_xor(ss, 2); ss += __shfl_xor(ss, 4); ss += __shfl_xor(ss, 8);
          rn = rsqrtf(ss + EPS);
        }
#pragma unroll
        for (int i = 0; i < 4; i++) pk[r].w[i] = pack2(o[r][2 * i] * rn, o[r][2 * i + 1] * rn);
      }
      if (seg < 2) {
        bf16* sd = seg == 0 ? sQ : sK;
        bf16* gd = (seg == 0 ? CQ2 : CK2) + (size_t)gr * 512 + h * 128 + cc * 8;
#pragma unroll
        for (int r = 0; r < 4; r++) {
          *(uint4*)(sd + (rg * 4 + r) * 136 + cc * 8) = pk[r].u;
          *(uint4*)(gd + (size_t)r * 512) = pk[r].u;
        }
      }
      if (seg >= 1) {
        bf16* st = seg == 1 ? sKT : sVT;
#pragma unroll
        for (int i = 0; i < 4; i++) {
          uint2 lo = make_uint2((pk[0].w[i] & 0xffffu) | (pk[1].w[i] << 16), (pk[2].w[i] & 0xffffu) | (pk[3].w[i] << 16));
          uint2 hi = make_uint2((pk[0].w[i] >> 16) | (pk[1].w[i] & 0xffff0000u), (pk[2].w[i] >> 16) | (pk[3].w[i] & 0xffff0000u));
          *(uint2*)(st + (cc * 8 + 2 * i) * 72 + rg * 4) = lo;
          *(uint2*)(st + (cc * 8 + 2 * i + 1) * 72 + rg * 4) = hi;
        }
      }
    }
  }
  if (tid < 128) {
    const int d = tid >> 6, t = tid & 63;
    const float* ba = (const float*)(p.ws + OFF_BA) + (size_t)(r0 + t) * 16;
    float bl = ba[d * 4 + h], al = ba[8 + d * 4 + h];
    float beta = sigm(bl);
    float x = al + p.in[19][l * 8 + d * 4 + h];
    float sp = x > 20.f ? x : log1pf(expf(x));
    float g = -expf(p.in[18][l * 8 + d * 4 + h]) * sp;
    if (d == 0) {
#pragma unroll
      for (int o = 1; o < 64; o <<= 1) { float v = __shfl_up(g, o); if (t >= o) g += v; }
    } else {
#pragma unroll
      for (int o = 1; o < 64; o <<= 1) { float v = __shfl_down(g, o); if (t + o < 64) g += v; }
    }
    sBeta[d * 64 + t] = beta;
    sGc[d * 64 + t] = g;
    ((float*)(p.ws + OFF_GC))[((size_t)(c * 4 + h) * 2 + d) * 64 + t] = g;
  }
  __syncthreads();
  f32x4 G[4], QK[4];
  {
#pragma unroll
    for (int j = 0; j < 4; j++) { G[j] = zero4(); QK[j] = zero4(); }
#pragma unroll
    for (int ks = 0; ks < 4; ks++) {
      bf16x8 ak = *(const bf16x8*)(sK + (wave * 16 + l16) * 136 + ks * 32 + quad * 8);
      bf16x8 aq = *(const bf16x8*)(sQ + (wave * 16 + l16) * 136 + ks * 32 + quad * 8);
#pragma unroll
      for (int j = 0; j < 4; j++) {
        bf16x8 bk = *(const bf16x8*)(sK + (j * 16 + l16) * 136 + ks * 32 + quad * 8);
        G[j] = mfma16(ak, bk, G[j]);
        QK[j] = mfma16(aq, bk, QK[j]);
      }
    }
  }
  __syncthreads();
  {
    bf16* QKD = (bf16*)(p.ws + OFF_QKD) + (size_t)(c * 4 + h) * 2 * 4096;
    const float scale = 0.08838834764831845f;
    float gcf_t[4], gcb_t[4], bf_t[4], bb_t[4];
#pragma unroll
    for (int e = 0; e < 4; e++) {
      const int t = wave * 16 + quad * 4 + e;
      gcf_t[e] = sGc[t]; gcb_t[e] = sGc[64 + t]; bf_t[e] = sBeta[t]; bb_t[e] = sBeta[64 + t];
    }
#pragma unroll
    for (int j = 0; j < 4; j++) {
      const int t2 = j * 16 + l16;
      const float gcf2 = sGc[t2], gcb2 = sGc[64 + t2];
#pragma unroll
      for (int e = 0; e < 4; e++) {
        const int t = wave * 16 + quad * 4 + e;
        const float ef = __expf(fminf(gcf_t[e] - gcf2, 0.f)), eb = __expf(fminf(gcb_t[e] - gcb2, 0.f));
        const float a0 = bf_t[e] * G[j][e] * ef, a1 = bb_t[e] * G[j][e] * eb;
        const float q0 = QK[j][e] * scale * ef, q1 = QK[j][e] * scale * eb;
        T0[t * 68 + t2] = (t2 < t) ? a0 : 0.f;
        T1[t * 68 + t2] = (t2 > t) ? a1 : 0.f;
        QKD[t * 64 + t2] = f2bf((t2 <= t) ? q0 : 0.f);
        QKD[4096 + t * 64 + t2] = f2bf((t2 >= t) ? q1 : 0.f);
      }
    }
  }
  __syncthreads();
  if (wave == 0) solve_tri<false>(T0, lane);
  else if (wave == 1) solve_tri<true>(T1, lane);
  __syncthreads();
  {
    bf16* U = (bf16*)(p.ws + OFF_U);
    bf16* W = (bf16*)(p.ws + OFF_W);
#pragma unroll 1
    for (int d = 0; d < 2; d++) {
      const float* T = d ? T1 : T0;
      bf16x8 au[2], aw[2];
#pragma unroll
      for (int ks = 0; ks < 2; ks++) {
        const int kk = ks * 32 + quad * 8;
        const float* tr = T + (wave * 16 + l16) * 68 + kk;
        float4 t0 = *(const float4*)tr, t1 = *(const float4*)(tr + 4);
        float tv[8] = {t0.x, t0.y, t0.z, t0.w, t1.x, t1.y, t1.z, t1.w};
        U8 pu, pw;
#pragma unroll
        for (int i = 0; i < 4; i++) {
          float b0 = sBeta[d * 64 + kk + 2 * i], b1 = sBeta[d * 64 + kk + 2 * i + 1];
          float e0 = __expf(sGc[d * 64 + kk + 2 * i]), e1 = __expf(sGc[d * 64 + kk + 2 * i + 1]);
          pu.w[i] = pack2(tv[2 * i] * b0, tv[2 * i + 1] * b1);
          pw.w[i] = pack2(tv[2 * i] * b0 * e0, tv[2 * i + 1] * b1 * e1);
        }
        au[ks] = pu.v; aw[ks] = pw.v;
      }
#pragma unroll 2
      for (int j = 0; j < 8; j++) {
        f32x4 a1 = zero4(), a2 = zero4();
#pragma unroll
        for (int ks = 0; ks < 2; ks++) {
          a1 = mfma16(*(const bf16x8*)(sVT + (j * 16 + l16) * 72 + ks * 32 + quad * 8), au[ks], a1);
          a2 = mfma16(*(const bf16x8*)(sKT + (j * 16 + l16) * 72 + ks * 32 + quad * 8), aw[ks], a2);
        }
        const int row = r0 + wave * 16 + l16;
        const size_t off = (size_t)d * M_TOT * 512 + (size_t)row * 512 + h * 128 + j * 16 + quad * 4;
        *(uint2*)(U + off) = make_uint2(pack2(a1[0], a1[1]), pack2(a1[2], a1[3]));
        *(uint2*)(W + off) = make_uint2(pack2(a2[0], a2[1]), pack2(a2[2], a2[3]));
      }
    }
  }
  __syncthreads();
}

DEV void gdn_chain_item(const Params& p, int l, int item, bf16* sm, bf16* smB) {
  const int tid = opaque_tid(), lane = tid & 63, wave = tid >> 6, l16 = lane & 15, quad = lane >> 4;
  const int s = item & 3, chain = item >> 2;
  bool lat; int b, h, d;
  if (chain < 32) { lat = true; b = chain >> 3; h = (chain >> 1) & 3; d = chain & 1; }
  else { int cc = chain - 32; lat = false; b = cc >> 3; h = (cc >> 1) & 3; d = cc & 1; }
  const int N = lat ? 64 : 4;
  const int cbase = lat ? 64 + b * 64 : b * 4;
  bf16* sW = sm;
  bf16* sQ = sm + 8704;
  bf16* sVN = sm + 17408;
  bf16* sKT = smB;
  bf16* sQK = smB + 9216;
  bf16* sST = smB + 13824;
  const bf16* Wg = (const bf16*)(p.ws + OFF_W) + (size_t)d * M_TOT * 512;
  const bf16* Ug = (const bf16*)(p.ws + OFF_U) + (size_t)d * M_TOT * 512;
  const bf16* CQ2 = (const bf16*)(p.ws + OFF_CQ2);
  const bf16* CK2 = (const bf16*)(p.ws + OFF_CK2);
  bf16* OD = (bf16*)(p.ws + (d ? OFF_CK : OFF_CQ));
  const float* GC = (const float*)(p.ws + OFF_GC);
  const bf16* QKDg = (const bf16*)(p.ws + OFF_QKD);
  const float scale = 0.08838834764831845f;
  f32x4 S[2][2];
  if (lat) {
    const float* s0 = p.in[5] + ((size_t)((b * 4 + l) * 2 + d) * 4 + h) * 16384;
#pragma unroll
    for (int i = 0; i < 2; i++)
#pragma unroll
      for (int j = 0; j < 2; j++)
#pragma unroll
        for (int e = 0; e < 4; e++) S[i][j][e] = s0[((2 * wave + i) * 16 + quad * 4 + e) * 128 + s * 32 + j * 16 + l16];
  } else {
#pragma unroll
    for (int i = 0; i < 2; i++)
#pragma unroll
      for (int j = 0; j < 2; j++) S[i][j] = zero4();
  }
  typedef unsigned int u32x4 __attribute__((ext_vector_type(4)));
  u32x4 rw[4], rq[4], rk[4], rqk[2];
  float rgt[4], rgl = 0.f;
  float ruu[2][4];
  auto chain_load = [&](int n) __attribute__((always_inline)) {
    const int c = cbase + (d == 0 ? n : N - 1 - n);
    const int r0 = c * 64;
    const float* gc = GC + ((size_t)(c * 4 + h) * 2 + d) * 64;
    rgl = d == 0 ? gc[63] : gc[0];
#pragma unroll
    for (int i = 0; i < 4; i++) {
      const int t = (tid >> 4) * 4 + i, k8 = (tid & 15) * 8;
      const size_t go = (size_t)(r0 + t) * 512 + h * 128 + k8;
      rw[i] = *(const u32x4*)(Wg + go);
      rq[i] = *(const u32x4*)(CQ2 + go);
      rk[i] = *(const u32x4*)(CK2 + go);
      rgt[i] = gc[t];
    }
#pragma unroll
    for (int i = 0; i < 2; i++) {
      const int ch = tid + 256 * i, t = ch >> 3, k8 = (ch & 7) * 8;
      rqk[i] = *(const u32x4*)(QKDg + ((size_t)(c * 4 + h) * 2 + d) * 4096 + t * 64 + k8);
    }
#pragma unroll
    for (int j = 0; j < 2; j++)
#pragma unroll
      for (int e = 0; e < 4; e++)
        ruu[j][e] = bf2f(Ug[(size_t)(r0 + wave * 16 + quad * 4 + e) * 512 + h * 128 + s * 32 + j * 16 + l16]);
  };
  chain_load(0);
  for (int n = 0; n < N; n++) {
    const int c = cbase + (d == 0 ? n : N - 1 - n);
    const int r0 = c * 64;
    const float glast = rgl;
#pragma unroll
    for (int i = 0; i < 2; i++)
#pragma unroll
      for (int j = 0; j < 2; j++) {
        uint2 pk = make_uint2(pack2(S[i][j][0], S[i][j][1]), pack2(S[i][j][2], S[i][j][3]));
        *(uint2*)(sST + (j * 16 + l16) * 136 + (2 * wave + i) * 16 + quad * 4) = pk;
      }
    {
      const int tg = tid >> 4, k8 = (tid & 15) * 8;
      float ksf[4];
#pragma unroll
      for (int i = 0; i < 4; i++) {
        const int t = tg * 4 + i;
        *(u32x4*)(sW + t * 136 + k8) = rw[i];
        const float gt = rgt[i];
        const float qs = scale * __expf(gt);
        ksf[i] = __expf(glast - gt);
        u32x4 qo;
#pragma unroll
        for (int w2 = 0; w2 < 4; w2++) qo[w2] = pack2(lo2f(rq[i][w2]) * qs, hi2f(rq[i][w2]) * qs);
        *(u32x4*)(sQ + t * 136 + k8) = qo;
      }
      const int gsw = ((tg >> 1) ^ ((tid & 15) & 7)) * 8 + (tg & 1) * 4;
#pragma unroll
      for (int w2 = 0; w2 < 4; w2++) {
        const uint2 lo = make_uint2(pack2(lo2f(rk[0][w2]) * ksf[0], lo2f(rk[1][w2]) * ksf[1]),
                                    pack2(lo2f(rk[2][w2]) * ksf[2], lo2f(rk[3][w2]) * ksf[3]));
        const uint2 hi = make_uint2(pack2(hi2f(rk[0][w2]) * ksf[0], hi2f(rk[1][w2]) * ksf[1]),
                                    pack2(hi2f(rk[2][w2]) * ksf[2], hi2f(rk[3][w2]) * ksf[3]));
        *(uint2*)(sKT + (k8 + 2 * w2) * 72 + gsw) = lo;
        *(uint2*)(sKT + (k8 + 2 * w2 + 1) * 72 + gsw) = hi;
      }
    }
#pragma unroll
    for (int i = 0; i < 2; i++) {
      const int ch = tid + 256 * i, t = ch >> 3, k8 = (ch & 7) * 8;
      *(u32x4*)(sQK + t * 72 + k8) = rqk[i];
    }
    float uu[2][4];
#pragma unroll
    for (int j = 0; j < 2; j++)
#pragma unroll
      for (int e = 0; e < 4; e++) uu[j][e] = ruu[j][e];
    chain_load(n + 1 < N ? n + 1 : n);
    __builtin_amdgcn_sched_barrier(0);
    __syncthreads();
    f32x4 vn[2];
    {
      vn[0] = zero4(); vn[1] = zero4();
#pragma unroll
      for (int ks = 0; ks < 4; ks++) {
        bf16x8 a = *(const bf16x8*)(sW + (wave * 16 + l16) * 136 + ks * 32 + quad * 8);
#pragma unroll
        for (int j = 0; j < 2; j++)
          vn[j] = mfma16(a, *(const bf16x8*)(sST + (j * 16 + l16) * 136 + ks * 32 + quad * 8), vn[j]);
      }
#pragma unroll
      for (int j = 0; j < 2; j++) {
#pragma unroll
        for (int e = 0; e < 4; e++) vn[j][e] = uu[j][e] - vn[j][e];
        uint2 pk = make_uint2(pack2(vn[j][0], vn[j][1]), pack2(vn[j][2], vn[j][3]));
        *(uint2*)(sVN + (j * 16 + l16) * 72 + wave * 16 + quad * 4) = pk;
      }
    }
    __syncthreads();
    {
      f32x4 o[2];
      o[0] = zero4(); o[1] = zero4();
#pragma unroll
      for (int ks = 0; ks < 4; ks++) {
        bf16x8 a = *(const bf16x8*)(sQ + (wave * 16 + l16) * 136 + ks * 32 + quad * 8);
#pragma unroll
        for (int j = 0; j < 2; j++)
          o[j] = mfma16(a, *(const bf16x8*)(sST + (j * 16 + l16) * 136 + ks * 32 + quad * 8), o[j]);
      }
#pragma unroll
      for (int ks = 0; ks < 2; ks++) {
        bf16x8 a = *(const bf16x8*)(sQK + (wave * 16 + l16) * 72 + ks * 32 + quad * 8);
#pragma unroll
        for (int j = 0; j < 2; j++)
          o[j] = mfma16(a, *(const bf16x8*)(sVN + (j * 16 + l16) * 72 + ks * 32 + quad * 8), o[j]);
      }
#pragma unroll
      for (int j = 0; j < 2; j++)
#pragma unroll
        for (int e = 0; e < 4; e++)
          OD[(size_t)(r0 + wave * 16 + quad * 4 + e) * 512 + h * 128 + s * 32 + j * 16 + l16] = f2bf(o[j][e]);
    }
    {
      const float eg = __expf(glast);
#pragma unroll
      for (int i = 0; i < 2; i++)
#pragma unroll
        for (int j = 0; j < 2; j++) {
#pragma unroll
          for (int e = 0; e < 4; e++) S[i][j][e] *= eg;
#pragma unroll
          for (int ks = 0; ks < 2; ks++)
            S[i][j] = mfma16(*(const bf16x8*)(sKT + ((2 * wave + i) * 16 + l16) * 72 + (((ks * 4 + quad) ^ ((((2 * wave + i) * 16 + l16) >> 3) & 7)) << 3)),
                             *(const bf16x8*)(sVN + (j * 16 + l16) * 72 + ks * 32 + quad * 8), S[i][j]);
        }
    }
    __syncthreads();
  }
  if (!lat) {
    float* o = p.out + OUT_GDN + ((size_t)((b * 4 + l) * 2 + d) * 4 + h) * 16384;
#pragma unroll
    for (int i = 0; i < 2; i++)
#pragma unroll
      for (int j = 0; j < 2; j++)
#pragma unroll
        for (int e = 0; e < 4; e++) o[((2 * wave + i) * 16 + quad * 4 + e) * 128 + s * 32 + j * 16 + l16] = S[i][j][e];
  }
}

DEV void phase_gdn_post(const Params& p, int l, int dry) {
  const int vbid = blockIdx.x * 2 + vhalf(), vnb = gridDim.x * 2;
  const int tid = opaque_tid(), lane = tid & 63, wave = tid >> 6;
  bf16* O0 = (bf16*)(p.ws + OFF_CQ);
  const bf16* O1 = (const bf16*)(p.ws + OFF_CK);
  const bf16* CZ = (const bf16*)(p.ws + OFF_CZ);
  const float* nw = p.in[20] + l * 128 + (lane & 15) * 8;
  const float4 w0 = *(const float4*)nw, w1 = *(const float4*)(nw + 4);
  const int gw = vbid * 4 + wave, nwt = vnb * 4;
  typedef unsigned int u32x4 __attribute__((ext_vector_type(4)));
  u32x4 pa = {0u, 0u, 0u, 0u}, pb2 = pa, pz = pa;
  if (gw < M_TOT) {
    const size_t off0 = ((size_t)gw * 4 + (lane >> 4)) * 128 + (lane & 15) * 8;
    pa = *(const u32x4*)(O0 + off0); pb2 = *(const u32x4*)(O1 + off0); pz = *(const u32x4*)(CZ + off0);
  }
  for (int t4 = gw; t4 < M_TOT; t4 += nwt) {
    const size_t off = ((size_t)t4 * 4 + (lane >> 4)) * 128 + (lane & 15) * 8;
    U8 a, b2, z;
    a.w[0] = pa[0]; a.w[1] = pa[1]; a.w[2] = pa[2]; a.w[3] = pa[3];
    b2.w[0] = pb2[0]; b2.w[1] = pb2[1]; b2.w[2] = pb2[2]; b2.w[3] = pb2[3];
    z.w[0] = pz[0]; z.w[1] = pz[1]; z.w[2] = pz[2]; z.w[3] = pz[3];
    {
      const int tn = (t4 + nwt < M_TOT) ? t4 + nwt : t4;
      const size_t offn = ((size_t)tn * 4 + (lane >> 4)) * 128 + (lane & 15) * 8;
      pa = *(const u32x4*)(O0 + offn); pb2 = *(const u32x4*)(O1 + offn); pz = *(const u32x4*)(CZ + offn);
    }
    float x[8];
    float ss = 0.f;
#pragma unroll
    for (int i = 0; i < 4; i++) {
      x[2 * i] = lo2f(a.w[i]) + lo2f(b2.w[i]);
      x[2 * i + 1] = hi2f(a.w[i]) + hi2f(b2.w[i]);
      ss += x[2 * i] * x[2 * i] + x[2 * i + 1] * x[2 * i + 1];
    }
    ss += __shfl_xor(ss, 1); ss += __shfl_xor(ss, 2); ss += __shfl_xor(ss, 4); ss += __shfl_xor(ss, 8);
    const float rstd = rsqrtf(ss * (1.f / 128.f) + EPS);
    U8 o;
    o.w[0] = pack2(x[0] * rstd * w0.x * lo2f(z.w[0]), x[1] * rstd * w0.y * hi2f(z.w[0]));
    o.w[1] = pack2(x[2] * rstd * w0.z * lo2f(z.w[1]), x[3] * rstd * w0.w * hi2f(z.w[1]));
    o.w[2] = pack2(x[4] * rstd * w1.x * lo2f(z.w[2]), x[5] * rstd * w1.y * hi2f(z.w[2]));
    o.w[3] = pack2(x[6] * rstd * w1.z * lo2f(z.w[3]), x[7] * rstd * w1.w * hi2f(z.w[3]));
    if (!dry) *(uint4*)(O0 + off) = o.u;
  }
}

struct AttnState {
  f32x4 O[2][8];
  f32x4 Os[2];
  float mx[2];
};
DEV void attn_qk(AttnState& st, const char* sK, const bf16x8 (&qf)[2][2], const int (&koff)[2], bf16x8 (&pb)[2][2]) {
  f32x4 S[4][2];
#pragma unroll
  for (int kti = 0; kti < 4; kti++) { S[kti][0] = zero4(); S[kti][1] = zero4(); }
#pragma unroll
  for (int ks = 0; ks < 2; ks++)
#pragma unroll
    for (int kti = 0; kti < 4; kti++) {
      bf16x8 a = *(const bf16x8*)(sK + koff[ks] + kti * 2048);
      S[kti][0] = mfma16(a, qf[0][ks], S[kti][0]);
      S[kti][1] = mfma16(a, qf[1][ks], S[kti][1]);
    }
#pragma unroll
  for (int qt = 0; qt < 2; qt++) {
    float tm = S[0][qt][0];
#pragma unroll
    for (int kti = 0; kti < 4; kti++)
#pragma unroll
      for (int e = 0; e < 4; e++) tm = fmaxf(tm, S[kti][qt][e]);
    if (__any(tm > st.mx[qt] + 8.f)) {
      tm = fmaxf(tm, __shfl_xor(tm, 16));
      tm = fmaxf(tm, __shfl_xor(tm, 32));
      const float mnew = fmaxf(st.mx[qt], tm);
      const float alpha = ex2(st.mx[qt] - mnew);
      st.mx[qt] = mnew;
#pragma unroll
      for (int dt = 0; dt < 8; dt++)
#pragma unroll
        for (int e = 0; e < 4; e++) st.O[qt][dt][e] *= alpha;
#pragma unroll
      for (int e = 0; e < 4; e++) st.Os[qt][e] *= alpha;
    }
    const float mref = st.mx[qt];
#pragma unroll
    for (int kti = 0; kti < 4; kti++)
#pragma unroll
      for (int e = 0; e < 4; e++) S[kti][qt][e] = ex2(S[kti][qt][e] - mref);
#pragma unroll
    for (int cch = 0; cch < 2; cch++) {
      U8 pk;
      pk.w[0] = pack2(S[2 * cch][qt][0], S[2 * cch][qt][1]);
      pk.w[1] = pack2(S[2 * cch][qt][2], S[2 * cch][qt][3]);
      pk.w[2] = pack2(S[2 * cch + 1][qt][0], S[2 * cch + 1][qt][1]);
      pk.w[3] = pack2(S[2 * cch + 1][qt][2], S[2 * cch + 1][qt][3]);
      pb[qt][cch] = pk.v;
    }
  }
  __builtin_amdgcn_sched_barrier(0);
}
DEV void attn_pv(AttnState& st, const char* sV, const bf16x8 (&pb)[2][2], const int (&voff)[2]) {
  U8 ones;
  ones.w[0] = 0x3F803F80u; ones.w[1] = 0x3F803F80u; ones.w[2] = 0x3F803F80u; ones.w[3] = 0x3F803F80u;
#pragma unroll
  for (int cch = 0; cch < 2; cch++) {
    st.Os[0] = mfma16(ones.v, pb[0][cch], st.Os[0]);
    st.Os[1] = mfma16(ones.v, pb[1][cch], st.Os[1]);
#pragma unroll
    for (int dt = 0; dt < 8; dt++) {
      const bf16x8 a = *(const bf16x8*)(sV + dt * 2048 + voff[cch]);
      st.O[0][dt] = mfma16(a, pb[0][cch], st.O[0][dt]);
      st.O[1][dt] = mfma16(a, pb[1][cch], st.O[1][dt]);
    }
  }
  __builtin_amdgcn_sched_barrier(0);
}

DEV void attn_item8(const Params& p, int l_in, int item, const Lds4& L, int dry) {
  int l = l_in;
  asm volatile("" : "+s"(l));
  const int tid = raw_tid(), lane = tid & 63, l16 = lane & 15, quad = lane >> 4;
  const int wave = __builtin_amdgcn_readfirstlane(tid >> 6);
  const int g = wave >> 1, m = wave & 1;
  bool lat; int b, h, qb;
  if (item < 512) { lat = true; b = item >> 7; h = (item >> 5) & 3; qb = item & 31; }
  else { int it = item - 512; lat = false; b = it >> 3; h = (it >> 1) & 3; qb = it & 1; }
  const int rowbase = lat ? M_CTX + b * 4096 + qb * 128 : b * 256 + qb * 128;
  const int nkt = lat ? 68 : 4;
  bf16* QA = (bf16*)(p.ws + OFF_QA);
  const bf16* KA = (const bf16*)(p.ws + OFF_KA);
  const bf16* KC = (const bf16*)(p.ws + OFF_KC);
  const bf16* VT = lat ? (const bf16*)(p.ws + OFF_VTL) + (size_t)(b * 4 + h) * 128 * 4352
                       : (const bf16*)(p.ws + OFF_VTC) + (size_t)(b * 4 + h) * 128 * 256;
  const int vts = lat ? 4352 : 256;
  float c08 = 0.8f;
  asm volatile("" : "+v"(c08));
  const float lam_init = c08 - 0.6f * expf(-0.3f * (float)l);
  float lam;
  {
    const float* lv = p.in[13] + l * 256;
    float a = lv[lane] * lv[64 + lane], c2 = lv[128 + lane] * lv[192 + lane];
#pragma unroll
    for (int o = 32; o >= 1; o >>= 1) { a += __shfl_xor(a, o); c2 += __shfl_xor(c2, o); }
    lam = expf(a) - expf(c2) + lam_init;
  }
  bf16x8 qf[2][2];
#pragma unroll
  for (int qt = 0; qt < 2; qt++)
#pragma unroll
    for (int ks = 0; ks < 2; ks++)
      qf[qt][ks] = *(const bf16x8*)(QA + (size_t)(rowbase + g * 32 + qt * 16 + l16) * 512 + h * 128 + m * 64 + ks * 32 + quad * 8);
  AttnState st;
#pragma unroll
  for (int qt = 0; qt < 2; qt++) {
    st.mx[qt] = -1e30f; st.Os[qt] = zero4();
#pragma unroll
    for (int dt = 0; dt < 8; dt++) st.O[qt][dt] = zero4();
  }
  unsigned ko[2], vo[2];
#pragma unroll
  for (int i = 0; i < 2; i++) {
    int r, c;
    stage_rc2(wave * 1024 + i * 8192 + lane * 16, r, c);
    ko[i] = (unsigned)((r & 63) * 512 + (r >> 6) * 64 + c) * 2u;
    {
      const int vb = wave * 1024 + i * 8192 + lane * 16, vr = vb >> 7, vg = (vb >> 4) & 7;
      vo[i] = (unsigned)(vr * vts + ((vg ^ ((vr >> 1) & 7)) << 3)) * 2u;
    }
  }
  int koff[2];
#pragma unroll
  for (int ks = 0; ks < 2; ks++) koff[ks] = lds_byte2(l16, ks * 32 + quad * 8) + m * 8192;
  int voff[2];
#pragma unroll
  for (int cch = 0; cch < 2; cch++) voff[cch] = l16 * 128 + (((cch * 4 + quad) ^ ((l16 >> 1) & 7)) << 4);
  auto kbase = [&](int kt) -> const bf16* {
    if (lat) return (kt < 64) ? KA + (size_t)(M_CTX + b * 4096 + kt * 64) * 512 + h * 128
                              : KC + (size_t)(b * 256 + (kt - 64) * 64) * 512 + h * 128;
    return KA + (size_t)(b * 256 + kt * 64) * 512 + h * 128;
  };
  auto stage = [&](char* sb, int kt) {
    const bf16* kp = kbase(kt);
    const bf16* vp = VT + kt * 64;
#pragma unroll
    for (int i = 0; i < 2; i++) {
      __builtin_amdgcn_global_load_lds((const unsigned*)((const char*)kp + ko[i]), (unsigned*)(sb + wave * 1024 + i * 8192), 16, 0, 0);
      __builtin_amdgcn_global_load_lds((const unsigned*)((const char*)vp + vo[i]), (unsigned*)(sb + 16384 + wave * 1024 + i * 8192), 16, 0, 0);
    }
    __builtin_amdgcn_sched_barrier(0);
  };
  auto stage_c = [&](char* sb, int kt) { stage(sb, kt < nkt ? kt : nkt - 1); };
  const bool lagB = wave >= 4;
  bf16x8 pb[2][2];
#pragma unroll
  for (int i = 0; i < 2; i++)
#pragma unroll
    for (int j = 0; j < 2; j++) { U8 z; z.u = make_uint4(0u, 0u, 0u, 0u); pb[i][j] = z.v; }
  __syncthreads();
  stage_c(L.a0, 0);
  stage_c(L.b0, 1);
#define ATTN_STEP(OBJ_CUR, OBJ_PREV, OBJ_NEXT2, KT)                                   \
  asm volatile("s_waitcnt vmcnt(4)" ::: "memory");                                     \
  __builtin_amdgcn_s_barrier();                                                        \
  stage_c(OBJ_NEXT2, (KT) + 2);                                                        \
  if (lagB && (KT) > 0) attn_pv(st, (OBJ_PREV) + 16384, pb, voff);             \
  attn_qk(st, OBJ_CUR, qf, koff, pb);                                                  \
  if (!lagB) attn_pv(st, (OBJ_CUR) + 16384, pb, voff);
  for (int kt = 0; kt < nkt; kt += 4) {
    ATTN_STEP(L.a0, L.b1, L.a1, kt)
    ATTN_STEP(L.b0, L.a0, L.b1, kt + 1)
    ATTN_STEP(L.a1, L.b0, L.a0, kt + 2)
    ATTN_STEP(L.b1, L.a1, L.b0, kt + 3)
  }
#undef ATTN_STEP
  if (lagB) attn_pv(st, L.b1 + 16384, pb, voff);
  WAIT_V0();
  __syncthreads();
  float* X = (float*)((g < 2) ? L.a0 : L.a1) - (g >> 1) * 64 * 132;
#pragma unroll
  for (int qt = 0; qt < 2; qt++) {
    const float inv = (m ? lam : 1.f) / st.Os[qt][0];
#pragma unroll
    for (int dt = 0; dt < 8; dt++)
#pragma unroll
      for (int e = 0; e < 4; e++) st.O[qt][dt][e] *= inv;
  }
  if (m == 1) {
#pragma unroll
    for (int qt = 0; qt < 2; qt++)
#pragma unroll
      for (int dt = 0; dt < 8; dt++)
        *(f32x4*)(X + (g * 32 + qt * 16 + l16) * 132 + dt * 16 + quad * 4) = st.O[qt][dt];
  }
  __syncthreads();
  if (m == 0 && !dry) {
    int rowbase2 = rowbase;
    asm volatile("" : "+s"(rowbase2));
    const bf16* AZ = (const bf16*)(p.ws + OFF_AZ);
    const float* sw = p.in[14] + l * 128;
#pragma unroll
    for (int qt = 0; qt < 2; qt++) {
      float ss = 0.f;
#pragma unroll
      for (int dt = 0; dt < 8; dt++) {
        f32x4 x1 = *(const f32x4*)(X + (g * 32 + qt * 16 + l16) * 132 + dt * 16 + quad * 4);
#pragma unroll
        for (int e = 0; e < 4; e++) {
          float v = st.O[qt][dt][e] - x1[e];
          st.O[qt][dt][e] = v;
          ss += v * v;
        }
      }
      ss += __shfl_xor(ss, 16);
      ss += __shfl_xor(ss, 32);
      const float rstd = rsqrtf(ss * (1.f / 128.f) + EPS) * (1.f - lam_init);
      const size_t rowoff = (size_t)(rowbase2 + g * 32 + qt * 16 + l16) * 512 + h * 128;
#pragma unroll
      for (int dt = 0; dt < 8; dt++) {
        const int dv = dt * 16 + quad * 4;
        float4 w4 = *(const float4*)(sw + dv);
        uint2 z = *(const uint2*)(AZ + rowoff + dv);
        uint2 o2;
        o2.x = pack2(st.O[qt][dt][0] * rstd * w4.x * lo2f(z.x), st.O[qt][dt][1] * rstd * w4.y * hi2f(z.x));
        o2.y = pack2(st.O[qt][dt][2] * rstd * w4.z * lo2f(z.y), st.O[qt][dt][3] * rstd * w4.w * hi2f(z.y));
        *(uint2*)(QA + rowoff + dv) = o2;
      }
    }
  }
}

template <int NT>
DEV void merge_tile(const Params& p, const Lds4& L, int mt, int ncol0) {
  const int tid = raw_tid(), lane = tid & 63;
  int l16 = lane & 15, quad = lane >> 4;
  const int wave = __builtin_amdgcn_readfirstlane(tid >> 6);
  const int wm = wave >> 2, wn = wave & 3;
  const bf16* H = (const bf16*)(p.ws + OFF_H);
  const bf16* WG = (const bf16*)(p.ws + OFF_WINT) + (size_t)5888 * 1024;
  const bf16* WB = (const bf16*)(p.ws + OFF_WBT);
  bf16* MG = (bf16*)(p.ws + OFF_U);
  uint32_t* gpl0 = (uint32_t*)(L.b0 + 16384);
  uint32_t* gpl1 = (uint32_t*)(L.b1 + 16384);
  f32x4 tot[8][NT];
  zero_acc<NT>(tot);
#pragma unroll 1
  for (int br = 0; br < 3; br++) {
    uint32_t gp[8][NT][2];
    {
      f32x4 acc[8][NT];
      zero_acc<NT>(acc);
      gemm_loop8<NT, true>(acc, H + (size_t)mt * 256 * 1024, 1024, WG + (size_t)(br * 1024 + ncol0) * 1024, 1024, 1024, L);
#pragma unroll
      for (int i = 0; i < 8; i++)
#pragma unroll
        for (int j = 0; j < NT; j++) {
          gp[i][j][0] = pack2(sigm(acc[i][j][0]), sigm(acc[i][j][1]));
          gp[i][j][1] = pack2(sigm(acc[i][j][2]), sigm(acc[i][j][3]));
        }
      if (NT == 2) {
#pragma unroll
        for (int i = 4; i < 8; i++)
#pragma unroll
          for (int j = 0; j < NT; j++) {
            uint32_t* gpl = (i < 6) ? gpl0 : gpl1;
            gpl[(((i - 4) & 1) * 4 + j * 2 + 0) * 512 + tid] = gp[i][j][0];
            gpl[(((i - 4) & 1) * 4 + j * 2 + 1) * 512 + tid] = gp[i][j][1];
          }
      }
    }
    {
      const bf16* A = (const bf16*)(p.ws + (br == 0 ? OFF_QA : (br == 1 ? OFF_BV : OFF_CQ)));
      f32x4 acc[8][NT];
      zero_acc<NT>(acc);
      gemm_loop8<NT, true>(acc, A + (size_t)mt * 256 * 512, 512, WB + (size_t)(br * 1024 + ncol0) * 512, 512, 512, L);
      if (NT == 2) {
#pragma unroll
        for (int i = 4; i < 8; i++)
#pragma unroll
          for (int j = 0; j < NT; j++) {
            const uint32_t* gpl = (i < 6) ? gpl0 : gpl1;
            gp[i][j][0] = gpl[(((i - 4) & 1) * 4 + j * 2 + 0) * 512 + tid];
            gp[i][j][1] = gpl[(((i - 4) & 1) * 4 + j * 2 + 1) * 512 + tid];
          }
      }
#pragma unroll
      for (int i = 0; i < 8; i++)
#pragma unroll
        for (int j = 0; j < NT; j++) {
          tot[i][j][0] += lo2f(gp[i][j][0]) * acc[i][j][0];
          tot[i][j][1] += hi2f(gp[i][j][0]) * acc[i][j][1];
          tot[i][j][2] += lo2f(gp[i][j][1]) * acc[i][j][2];
          tot[i][j][3] += hi2f(gp[i][j][1]) * acc[i][j][3];
        }
    }
  }
  asm volatile("" : "+v"(l16), "+v"(quad));
  const int row0 = mt * 256 + wm * 128, col0 = ncol0 + wn * NT * 16;
#pragma unroll
  for (int i = 0; i < 8; i++) {
    bf16* d = MG + (size_t)(row0 + i * 16 + l16) * 1024 + col0 + quad * 4;
#pragma unroll
    for (int j = 0; j < NT; j++) *(uint2*)(d + j * 16) = make_uint2(pack2(tot[i][j][0], tot[i][j][1]), pack2(tot[i][j][2], tot[i][j][3]));
  }
}
DEV void phase_merge(const Params& p, int l, const Lds4& L) {
  const int vbx = xcd_compact_bid();
  for (int tile = vbx; tile < 512; tile += gridDim.x) merge_tile<2>(p, L, tile >> 3, (tile & 7) * 128);
  for (int t = vbx; t < 256; t += gridDim.x) merge_tile<1>(p, L, 64 + (t >> 4), (t & 15) * 64);
}

template <int NT>
DEV void out_tile(const Params& p, int l, const Lds4& L, int mt, int ncol0) {
  const int tid = raw_tid(), lane = tid & 63;
  int l16 = lane & 15, quad = lane >> 4;
  const int wave = __builtin_amdgcn_readfirstlane(tid >> 6);
  const int wm = wave >> 2, wn = wave & 3;
  const bf16* MG = (const bf16*)(p.ws + OFF_U);
  const bf16* WO = (const bf16*)(p.ws + OFF_WOT);
  const float* mod = (const float*)(p.ws + OFF_MOD);
  f32x4 acc[8][NT];
  zero_acc<NT>(acc);
  gemm_loop8<NT, true>(acc, MG + (size_t)mt * 256 * 1024, 1024, WO + (size_t)ncol0 * 1024, 1024, 1024, L);
  asm volatile("" : "+v"(l16), "+v"(quad));
  const int row0 = mt * 256 + wm * 128, col0 = ncol0 + wn * NT * 16;
  const int ci = row0 < M_CTX ? 0 : 1 + ((row0 - M_CTX) >> 12);
  const float* gate = mod + (l * 5 + ci) * 3072 + 2048 + col0 + quad * 4;
  float4 gv[NT];
#pragma unroll
  for (int j = 0; j < NT; j++) gv[j] = *(const float4*)(gate + j * 16);
#pragma unroll
  for (int i = 0; i < 8; i++) {
    const int row = row0 + i * 16 + l16;
    const float* xs;
    if (l == 0) xs = row < M_CTX ? p.in[0] + (size_t)row * 1024 : p.in[1] + (size_t)(row - M_CTX) * 1024;
    else xs = p.out + (size_t)row * 1024;
    float* xo = p.out + (size_t)row * 1024 + col0 + quad * 4;
    xs += col0 + quad * 4;
#pragma unroll
    for (int j = 0; j < NT; j++) {
      const float4 xv = *(const float4*)(xs + j * 16);
      float4 o;
      o.x = xv.x + gv[j].x * acc[i][j][0]; o.y = xv.y + gv[j].y * acc[i][j][1];
      o.z = xv.z + gv[j].z * acc[i][j][2]; o.w = xv.w + gv[j].w * acc[i][j][3];
      *(float4*)(xo + j * 16) = o;
    }
  }
}
DEV void phase_out(const Params& p, int l, const Lds4& L) {
  const int vbx = xcd_compact_bid();
  for (int tile = vbx; tile < 512; tile += gridDim.x) out_tile<2>(p, l, L, tile >> 3, (tile & 7) * 128);
  for (int t = vbx; t < 256; t += gridDim.x) out_tile<1>(p, l, L, 64 + (t >> 4), (t & 15) * 64);
}


#define XB_TMO      128
#define XB_XCNT(j)  (256  + 64 * (j))
#define XB_XSUB(j)  (1280 + 64 * (j))
#define XB_XGEN(j)  (2304 + 64 * (j))
#define XB_TOP      3328
#define XB_TOPGEN   3392
#define XCD_BAR_WORDS 3456
#define XB_SPIN_CAP (1u << 18)
#define LAS __attribute__((address_space(3)))
DEV unsigned xb_ld(unsigned* p) { return __hip_atomic_load(p, __ATOMIC_RELAXED, __HIP_MEMORY_SCOPE_AGENT); }
DEV unsigned xb_add(unsigned* p, unsigned v) { return __hip_atomic_fetch_add(p, v, __ATOMIC_RELAXED, __HIP_MEMORY_SCOPE_AGENT); }
DEV unsigned xb_xcc_id() { return (unsigned)__builtin_amdgcn_s_getreg((3 << 11) | 20) & 0xFu; }
#define XB_SPIN(cond, bar) do { unsigned _sp = 0; while (cond) { __builtin_amdgcn_s_sleep(1); \
    if ((++_sp & 255u) == 0u) { if (xb_ld(&(bar)[XB_TMO])) break; if (_sp > XB_SPIN_CAP) { atomicAdd(&(bar)[XB_TMO], 1u); break; } } } } while (0)
struct XcdBarrier { unsigned* bar; unsigned x; volatile LAS unsigned* st; };
DEV XcdBarrier xcd_barrier_post(unsigned* bar, volatile LAS unsigned* st) {
  XcdBarrier b; b.bar = bar; b.x = xb_xcc_id(); b.st = st;
  if (threadIdx.x == 0) (void)xb_add(&bar[XB_XCNT(b.x)], 1u);
  return b;
}
DEV void xcd_barrier_complete(unsigned* bar, unsigned x, unsigned& nloc, unsigned& nx) {
  const unsigned G = gridDim.x * gridDim.y * gridDim.z;
  unsigned sum, cnt, mine, sp = 0u;
  for (;;) {
    sum = 0u; cnt = 0u; mine = 0u;
#pragma unroll
    for (unsigned j = 0; j < 16; ++j) { const unsigned c = xb_ld(&bar[XB_XCNT(j)]); sum += c; cnt += (c > 0u) ? 1u : 0u; mine = (j == x) ? c : mine; }
    if (sum == G) break;
    __builtin_amdgcn_s_sleep(1);
    if ((++sp & 255u) == 0u) { if (xb_ld(&bar[XB_TMO])) break; if (sp > XB_SPIN_CAP) { atomicAdd(&bar[XB_TMO], 1u); break; } }
  }
  nloc = mine > 0u ? mine : 1u; nx = cnt > 0u ? cnt : 1u;
}
DEV void xcd_barrier(const XcdBarrier& b) {
  asm volatile("s_waitcnt vmcnt(0)" ::: "memory");
  __syncthreads();
  if (threadIdx.x == 0) {
    unsigned* bar = b.bar;
    __builtin_amdgcn_s_waitcnt(0);
    unsigned nloc = b.st[0], nx = b.st[1];
    if (nloc == 0u) { xcd_barrier_complete(bar, b.x, nloc, nx); b.st[0] = nloc; b.st[1] = nx; }
    const unsigned old = xb_add(&bar[XB_XSUB(b.x)], 1u);
    const unsigned gen = old / nloc;
    if (old + 1u == (gen + 1u) * nloc) {
      __builtin_amdgcn_fence(__ATOMIC_RELEASE, "agent");
      asm volatile("s_waitcnt vmcnt(0)" ::: "memory");
      const unsigned og = xb_add(&bar[XB_TOP], 1u);
      const unsigned tg = og / nx;
      if (og + 1u == (tg + 1u) * nx) xb_add(&bar[XB_TOPGEN], 1u);
      else XB_SPIN(xb_ld(&bar[XB_TOPGEN]) == tg, bar);
      __builtin_amdgcn_fence(__ATOMIC_ACQUIRE, "agent");
      xb_add(&bar[XB_XGEN(b.x)], 1u);
      asm volatile("s_waitcnt vmcnt(0)" ::: "memory");
    } else {
      XB_SPIN(xb_ld(&bar[XB_XGEN(b.x)]) == gen, bar);
      __builtin_amdgcn_fence(__ATOMIC_ACQUIRE, "agent");
      asm volatile("s_waitcnt vmcnt(0)" ::: "memory");
    }
  }
  __syncthreads();
}

#define DUP_PROJ 0
#define DUP_MERGE 0
#define DUP_CHAIN 0
#define DUP_PREP 0
#define DUP_SYNC 0
#define DUP_NORM 0
#define DUP_POST 0
#if DUP_SYNC
#define GSYNC() do { xcd_barrier(xb); xcd_barrier(xb); } while (0)
#else
#define GSYNC() xcd_barrier(xb)
#endif
#define DUP_ATTN 0
__global__ void __launch_bounds__(512, 2) fwd_megakernel(Params p) {
  cg::grid_group grid = cg::this_grid();
  __shared__ __attribute__((aligned(1024))) unsigned char smA0[40960];
  __shared__ __attribute__((aligned(1024))) unsigned char smB0[36864];
  __shared__ __attribute__((aligned(1024))) unsigned char smA1[40960];
  __shared__ __attribute__((aligned(1024))) unsigned char smB1[36864];
  __shared__ int s_item;
  __shared__ uint4 xb_words;
  const int hv = vhalf();
  bf16* sm = (bf16*)(hv ? smA1 : smA0);
  bf16* smB = (bf16*)(hv ? smB1 : smB0);
  Lds4 L4;
  L4.a0 = (char*)smA0; L4.b0 = (char*)smB0; L4.a1 = (char*)smA1; L4.b1 = (char*)smB1;
  float* smf = (float*)sm;
  const int vbid = blockIdx.x * 2 + hv, vnb = gridDim.x * 2;
  const int vbidc = xcd_compact_bid() * 2 + hv;
  if (threadIdx.x == 0) xb_words = make_uint4(0u, 0u, 0u, 0u);
  __syncthreads();
  XcdBarrier xb = xcd_barrier_post((unsigned*)(p.ws + OFF_BAR), (volatile LAS unsigned*)&xb_words);
  phase_mod(p, smf);
  grid.sync();
#pragma unroll 1
  for (int l0 = 0; l0 < 4; l0++) {
    int l = l0;
    asm volatile("" : "+s"(l));
    {
      int reps = 1 + DUP_NORM;
      asm volatile("" : "+s"(reps));
#pragma unroll 1
      for (int r = 0; r < reps; r++) { phase_norm(p, l); phase_cvt(p, l, smf); }
    }
    GSYNC();
    {
      int reps = 1 + DUP_PROJ;
      asm volatile("" : "+s"(reps));
#pragma unroll 1
      for (int r = 0; r < reps; r++) phase_proj(p, l, L4);
    }
    GSYNC();
    int nxtq = 0;
    if (raw_tid() == 0) nxtq = atomicAdd((int*)(p.ws + OFF_BAR + 14336) + 8 + l, 1);
    for (;;) {
      __syncthreads();
      if (raw_tid() == 0) s_item = nxtq;
      __syncthreads();
      const int q = __builtin_amdgcn_readfirstlane(s_item);
      if (q >= 1280) break;
      if (raw_tid() == 0) nxtq = atomicAdd((int*)(p.ws + OFF_BAR + 14336) + 8 + l, 1);
      const int it = q * 2 + hv;
      if (it < 1280) gdn_prep_item(p, l, it, sm, smB);
      else ret_prep_item(p, l, it - 1280, sm);
    }
    GSYNC();
    {
      int reps = 1 + DUP_CHAIN;
      asm volatile("" : "+s"(reps));
#pragma unroll 1
      for (int r = 0; r < reps; r++)
        for (int it = vbidc; it < 640; it += vnb) gdn_chain_item(p, l, it, sm, smB);
    }
    for (int it = vbidc + 640; it < 1280; it += vnb) ret_scan_item(p, l, it - 640);
#if DUP_ATTN
    {
      int reps = 2;
      asm volatile("" : "+s"(reps));
#pragma unroll 1
      for (int r = 0; r < reps; r++) {
        const int dry = (r + 1 < reps) ? 1 : 0;
        for (;;) {
          __syncthreads();
          if (raw_tid() == 0) s_item = atomicAdd((int*)(p.ws + OFF_BAR + 14336) + l * 2 + dry, 1);
          __syncthreads();
          const int it = __builtin_amdgcn_readfirstlane(s_item);
          if (it >= 640) break;
          attn_item8(p, l, it, L4, dry);
        }
      }
    }
#else
    for (;;) {
      __syncthreads();
      if (raw_tid() == 0) s_item = atomicAdd((int*)(p.ws + OFF_BAR + 14336) + l, 1);
      __syncthreads();
      const int it = __builtin_amdgcn_readfirstlane(s_item);
      if (it >= 640) break;
      attn_item8(p, l, it, L4, 0);
    }
#endif
    GSYNC();
    {
      int reps = 1 + DUP_POST;
      asm volatile("" : "+s"(reps));
#pragma unroll 1
      for (int r = 0; r < reps; r++) {
        const int dry = (r + 1 < reps) ? 1 : 0;
        for (int it = vbid; it < 1280; it += vnb) ret_post_item(p, l, it, sm, smB, dry);
        phase_gdn_post(p, l, dry);
      }
    }
    GSYNC();
    {
      int reps = 1 + DUP_MERGE;
      asm volatile("" : "+s"(reps));
#pragma unroll 1
      for (int r = 0; r < reps; r++) phase_merge(p, l, L4);
    }
    GSYNC();
    phase_out(p, l, L4);
    GSYNC();
  }
}

extern "C" void kernel_launch(void* const* d_in, const int* in_sizes, int n_in, void* d_out, int out_size, void* d_ws,
                              size_t ws_size, hipStream_t stream) {
  static int grid_blocks = 0;
  if (!grid_blocks) {
    int dev = 0, cus = 0, per_cu = 0;
    (void)hipGetDevice(&dev);
    (void)hipDeviceGetAttribute(&cus, hipDeviceAttributeMultiprocessorCount, dev);
    (void)hipOccupancyMaxActiveBlocksPerMultiprocessor(&per_cu, fwd_megakernel, 512, 0);
    if (per_cu > 1) per_cu = 1;
    if (per_cu < 1) per_cu = 1;
    grid_blocks = cus * per_cu;
  }
  if (ws_size < WS_NEED) {
    fprintf(stderr, "workspace too small: %zu < %zu\n", ws_size, (size_t)WS_NEED);
    return;
  }
  Params p{};
  for (int i = 0; i < 23; i++) p.in[i] = (const float*)d_in[i];
  p.out = (float*)d_out;
  p.ws = (unsigned char*)d_ws;
  (void)hipMemsetAsync((unsigned char*)d_ws + OFF_BAR, 0, 16384, stream);
  void* args[] = {&p};
  hipError_t e = hipLaunchCooperativeKernel((const void*)fwd_megakernel, dim3(grid_blocks), dim3(512), args, 0, stream);
  if (e != hipSuccess) fprintf(stderr, "cooperative launch failed: %s (grid %d)\n", hipGetErrorString(e), grid_blocks);
}
```

```cpp
#include <hip/hip_runtime.h>
#include <hip/hip_cooperative_groups.h>
#include <stdint.h>
#include <cstdio>
namespace cg = cooperative_groups;

typedef unsigned short bf16;
typedef __attribute__((ext_vector_type(8))) short bf16x8;
typedef __attribute__((ext_vector_type(4))) float f32x4;
#define DEV __device__ __forceinline__

constexpr int M_TOT = 20480;
constexpr int M_CTX = 4096;
constexpr float EPS = 1e-6f;

constexpr size_t SZ512 = (size_t)M_TOT * 512 * 2;
constexpr size_t OFF_MOD = 0;
constexpr size_t OFF_CNT = OFF_MOD + 245760;
constexpr size_t OFF_CS = OFF_CNT + 256;
constexpr size_t OFF_WINT = OFF_CS + 8192;
constexpr size_t OFF_WBT = OFF_WINT + 18350080;
constexpr size_t OFF_WOT = OFF_WBT + 3145728;
constexpr size_t OFF_H = OFF_WOT + 2097152;
constexpr size_t OFF_QA = OFF_H + 41943040;
constexpr size_t OFF_KA = OFF_QA + SZ512;
constexpr size_t OFF_AZ = OFF_KA + SZ512;
constexpr size_t OFF_BQ = OFF_AZ + SZ512;
constexpr size_t OFF_BK = OFF_BQ + SZ512 / 2;
constexpr size_t OFF_BV = OFF_BK + SZ512 / 2;
constexpr size_t OFF_BZ = OFF_BV + SZ512;
constexpr size_t OFF_CQ = OFF_BZ + SZ512;
constexpr size_t OFF_CK = OFF_CQ + SZ512;
constexpr size_t OFF_CV = OFF_CK + SZ512;
constexpr size_t OFF_CZ = OFF_CV + SZ512;
constexpr size_t OFF_BA = OFF_CZ + SZ512;
constexpr size_t OFF_VTC = OFF_BA + 1310720;
constexpr size_t OFF_VTL = OFF_VTC + 4194304;
constexpr size_t OFF_KC = OFF_VTL + 17825792;
constexpr size_t OFF_CQ2 = OFF_KC + 1048576;
constexpr size_t OFF_CK2 = OFF_CQ2 + SZ512;
constexpr size_t OFF_U = OFF_CK2 + SZ512;
constexpr size_t OFF_W = OFF_U + 2 * SZ512;
constexpr size_t OFF_QKD = OFF_W + 2 * SZ512;
constexpr size_t OFF_GC = OFF_QKD + 20971520;
constexpr size_t OFF_RU = OFF_GC + 655360;
constexpr size_t OFF_BAR = OFF_RU + 41943040;
constexpr size_t OFF_W2 = OFF_BAR + 16384;
constexpr size_t WS_NEED = OFF_W2 + 23592960;
constexpr size_t WSET_WBT = 18350080, WSET_WOT = 18350080 + 3145728;

constexpr size_t OUT_K = 20971520;
constexpr size_t OUT_V = 29360128;
constexpr size_t OUT_RET = 37748736;
constexpr size_t OUT_GDN = 41943040;

struct Params {
  const float* in[23];
  float* out;
  unsigned char* ws;
};

union U8 {
  uint4 u;
  bf16x8 v;
  uint2 h[2];
  uint32_t w[4];
};

typedef __bf16 bf16v2 __attribute__((ext_vector_type(2)));
DEV bf16 f2bf(float f) { return __builtin_bit_cast(unsigned short, (__bf16)f); }
DEV float bf2f(bf16 b) { return __uint_as_float(((uint32_t)b) << 16); }
DEV uint32_t pack2(float a, float b) { bf16v2 v; v[0] = (__bf16)a; v[1] = (__bf16)b; return __builtin_bit_cast(uint32_t, v); }
DEV float lo2f(uint32_t w) { return __uint_as_float(w << 16); }
DEV float hi2f(uint32_t w) { return __uint_as_float(w & 0xffff0000u); }
DEV float sigm(float x) { return __builtin_amdgcn_rcpf(1.f + __expf(-x)); }
DEV float silu(float x) { return x * __builtin_amdgcn_rcpf(1.f + __expf(-x)); }
DEV f32x4 mfma16(bf16x8 a, bf16x8 b, f32x4 c) { return __builtin_amdgcn_mfma_f32_16x16x32_bf16(a, b, c, 0, 0, 0); }
DEV int raw_tid() { int t = threadIdx.x; asm volatile("" : "+v"(t)); return t; }
DEV int opaque_tid() { return raw_tid() & 255; }
DEV int vhalf() { return __builtin_amdgcn_readfirstlane(raw_tid() >> 8); }
DEV float ex2(float x) { return __builtin_amdgcn_exp2f(x); }
DEV int vperm(int t) { return (t & ~31) + ((t >> 2) & 3) * 8 + ((t >> 4) & 1) * 4 + (t & 3); }
DEV unsigned char* wset(const Params& p, int l) { return p.ws + ((l & 1) ? OFF_W2 : OFF_WINT); }
DEV f32x4 zero4() { f32x4 z = {0.f, 0.f, 0.f, 0.f}; return z; }

DEV void phase_mod(const Params& p, float* sm) {
  const int vbid = blockIdx.x * 2 + vhalf(), vnb = gridDim.x * 2;
  const int tid = opaque_tid();
  float* sc = sm;
  float* red = sm + 5120;
  const float* c = p.in[6];
  const float* cctx = p.in[7];
  for (int i = tid; i < 5120; i += 256) {
    int ci = i >> 10, k = i & 1023;
    float v = ci == 0 ? cctx[k] : c[(ci - 1) * 1024 + k];
    sc[i] = silu(v);
  }
  __syncthreads();
  float* mod = (float*)(p.ws + OFF_MOD);
  for (int item = vbid; item < 192; item += vnb) {
    int l = item / 48, jb = item % 48;
    int jj = tid & 63, kq = tid >> 6;
    const float* W = p.in[9] + (size_t)l * 1024 * 3072 + jb * 64 + jj;
    float a0 = 0, a1 = 0, a2 = 0, a3 = 0, a4 = 0;
    for (int k = kq * 256; k < kq * 256 + 256; k++) {
      float w = W[(size_t)k * 3072];
      a0 += sc[k] * w; a1 += sc[1024 + k] * w; a2 += sc[2048 + k] * w; a3 += sc[3072 + k] * w; a4 += sc[4096 + k] * w;
    }
    red[(kq * 5 + 0) * 64 + jj] = a0; red[(kq * 5 + 1) * 64 + jj] = a1; red[(kq * 5 + 2) * 64 + jj] = a2;
    red[(kq * 5 + 3) * 64 + jj] = a3; red[(kq * 5 + 4) * 64 + jj] = a4;
    __syncthreads();
    for (int o = tid; o < 320; o += 256) {
      int ci = o >> 6, j2 = o & 63;
      float s = red[(0 * 5 + ci) * 64 + j2] + red[(1 * 5 + ci) * 64 + j2] + red[(2 * 5 + ci) * 64 + j2] + red[(3 * 5 + ci) * 64 + j2];
      s += p.in[10][l * 3072 + jb * 64 + j2];
      mod[(l * 5 + ci) * 3072 + jb * 64 + j2] = s;
    }
    __syncthreads();
  }
  if (vbid == vnb - 1) {
    float2* cs = (float2*)(p.ws + OFF_CS);
    for (int i = tid; i < 1024; i += 256) {
      int pos = i >> 4, f = i & 15;
      float inv = 1.0f / powf(10000.0f, (float)f / 16.0f);
      float ang = (float)pos * inv;
      cs[i] = make_float2(cosf(ang), sinf(ang));
    }
  }
}

struct CvtT { const float* src; bf16* dst; int ld, k0, c0, nv, dld, r0; };
DEV CvtT cvt_params(const Params& p, int l, int id) {
  CvtT t;
  if (id < 2240) {
    int nt = id >> 4, kt = id & 15;
    int srccol0, nvalid;
    if (nt < 92) { srccol0 = nt * 64; nvalid = 5648 - nt * 64; if (nvalid > 64) nvalid = 64; if (nvalid < 0) nvalid = 0; if (nvalid == 0) srccol0 = 0; }
    else { srccol0 = 5648 + (nt - 92) * 64; nvalid = 64; }
    t.src = p.in[11] + (size_t)l * 1024 * 8720; t.ld = 8720; t.k0 = kt * 64; t.c0 = srccol0; t.nv = nvalid;
    t.dst = (bf16*)wset(p, l); t.dld = 1024; t.r0 = nt * 64;
  } else if (id < 2624) {
    int q = id - 2240;
    int br = q >> 7, r = q & 127, nt = r >> 3, kt = r & 7;
    t.src = p.in[21] + (size_t)(l * 3 + br) * 512 * 1024; t.ld = 1024; t.k0 = kt * 64; t.c0 = nt * 64; t.nv = 64;
    t.dst = (bf16*)(wset(p, l) + WSET_WBT) + (size_t)br * 1024 * 512; t.dld = 512; t.r0 = nt * 64;
  } else {
    int q = id - 2624;
    int nt = q >> 4, kt = q & 15;
    t.src = p.in[22] + (size_t)l * 1024 * 1024; t.ld = 1024; t.k0 = kt * 64; t.c0 = nt * 64; t.nv = 64;
    t.dst = (bf16*)(wset(p, l) + WSET_WOT); t.dld = 1024; t.r0 = nt * 64;
  }
  return t;
}
DEV void cvt_load(const CvtT& t, float (&v)[16], int tid) {
  const int n = tid & 63, kk = tid >> 6;
#pragma unroll
  for (int i = 0; i < 16; i++) {
    const int k = i * 4 + kk;
    v[i] = (n < t.nv) ? t.src[(size_t)(t.k0 + k) * t.ld + t.c0 + n] : 0.f;
  }
}
DEV void cvt_store(const CvtT& t, const float (&v)[16], float* sm, int tid) {
  {
    const int n = tid & 63, kk = tid >> 6;
#pragma unroll
    for (int i = 0; i < 16; i++) sm[(i * 4 + kk) * 65 + n] = v[i];
  }
  __syncthreads();
  {
    int n = tid >> 2, kc = (tid & 3) * 16;
    U8 a, b;
#pragma unroll
    for (int i = 0; i < 4; i++) {
      a.w[i] = pack2(sm[(kc + 2 * i) * 65 + n], sm[(kc + 2 * i + 1) * 65 + n]);
      b.w[i] = pack2(sm[(kc + 8 + 2 * i) * 65 + n], sm[(kc + 8 + 2 * i + 1) * 65 + n]);
    }
    bf16* d = t.dst + (size_t)(t.r0 + n) * t.dld + t.k0 + kc;
    *(uint4*)d = a.u;
    *(uint4*)(d + 8) = b.u;
  }
  __syncthreads();
}

DEV void phase_cvt(const Params& p, int l, float* sm) {
  const int vbid = blockIdx.x * 2 + vhalf(), vnb = gridDim.x * 2;
  const int tid = opaque_tid();
  int id = vbid;
  if (id >= 2880) return;
  CvtT t = cvt_params(p, l, id);
  float v[16];
  cvt_load(t, v, tid);
  for (; id < 2880; id += vnb) {
    const int nid = id + vnb;
    const CvtT tn = cvt_params(p, l, nid < 2880 ? nid : id);
    float vn[16];
    cvt_load(tn, vn, tid);
    cvt_store(t, v, sm, tid);
    t = tn;
#pragma unroll
    for (int i = 0; i < 16; i++) v[i] = vn[i];
  }
}

DEV void phase_norm(const Params& p, int l) {
  const int vbid = blockIdx.x * 2 + vhalf(), vnb = gridDim.x * 2;
  const int tid = opaque_tid(), lane = tid & 63, wave = tid >> 6;
  const float* mod = (const float*)(p.ws + OFF_MOD);
  const float* nw = p.in[8] + l * 1024;
  bf16* H = (bf16*)(p.ws + OFF_H);
  const int gw = vbid * 4 + wave, nw_tot = vnb * 4;
  auto xrow = [&](int row) -> const float* {
    if (l == 0) return row < M_CTX ? p.in[0] + (size_t)row * 1024 : p.in[1] + (size_t)(row - M_CTX) * 1024;
    return p.out + (size_t)row * 1024;
  };
  float4 v[4];
  if (gw < M_TOT) {
    const float* x = xrow(gw);
#pragma unroll
    for (int i = 0; i < 4; i++) v[i] = *(const float4*)(x + i * 256 + lane * 4);
  }
  for (int row = gw; row < M_TOT; row += nw_tot) {
    float4 vn[4];
    const int nrow = row + nw_tot;
    if (nrow < M_TOT) {
      const float* xn = xrow(nrow);
#pragma unroll
      for (int i = 0; i < 4; i++) vn[i] = *(const float4*)(xn + i * 256 + lane * 4);
    } else {
#pragma unroll
      for (int i = 0; i < 4; i++) vn[i] = make_float4(0.f, 0.f, 0.f, 0.f);
    }
    int ci = row < M_CTX ? 0 : 1 + ((row - M_CTX) >> 12);
    const float* md = mod + (l * 5 + ci) * 3072;
    float ss = 0.f;
#pragma unroll
    for (int i = 0; i < 4; i++) ss += v[i].x * v[i].x + v[i].y * v[i].y + v[i].z * v[i].z + v[i].w * v[i].w;
#pragma unroll
    for (int o = 32; o >= 1; o >>= 1) ss += __shfl_xor(ss, o);
    float rstd = rsqrtf(ss * (1.f / 1024.f) + EPS);
#pragma unroll
    for (int i = 0; i < 4; i++) {
      int k = i * 256 + lane * 4;
      float4 w4 = *(const float4*)(nw + k);
      float4 sh = *(const float4*)(md + k);
      float4 sc = *(const float4*)(md + 1024 + k);
      float h0 = v[i].x * rstd * w4.x * (1.f + sc.x) + sh.x;
      float h1 = v[i].y * rstd * w4.y * (1.f + sc.y) + sh.y;
      float h2 = v[i].z * rstd * w4.z * (1.f + sc.z) + sh.z;
      float h3 = v[i].w * rstd * w4.w * (1.f + sc.w) + sh.w;
      uint2 o2 = make_uint2(pack2(h0, h1), pack2(h2, h3));
      *(uint2*)(H + (size_t)row * 1024 + k) = o2;
    }
#pragma unroll
    for (int i = 0; i < 4; i++) v[i] = vn[i];
  }
  bf16* KC = (bf16*)(p.ws + OFF_KC);
  bf16* VTL = (bf16*)(p.ws + OFF_VTL);
  const int gt = vbid * 256 + tid, nt = vnb * 256;
  for (int i = gt; i < 4 * 256 * 512; i += nt) {
    int b = i >> 17, s = (i >> 9) & 255, cc = i & 511;
    size_t src = ((size_t)(b * 4 + l) * 256 + s) * 512 + cc;
    KC[i] = f2bf(p.in[2][src]);
    int h = cc >> 7, dv = cc & 127;
    VTL[((size_t)(b * 4 + h) * 128 + dv) * 4352 + 4096 + vperm(s)] = f2bf(p.in[3][src]);
  }
}

DEV int lds_byte2(int r, int c) {
  int st = (r >> 4) * 2 + (c >> 5), ob = (r & 15) * 64 + (c & 31) * 2;
  return st * 1024 + (ob ^ (((ob >> 9) & 1) << 5));
}
DEV void stage_rc2(int b, int& R, int& C) {
  int st = b >> 10, sb = b & 1023, swz = sb ^ (((sb >> 9) & 1) << 5);
  R = (st >> 1) * 16 + swz / 64;
  C = (st & 1) * 32 + (swz % 64) / 2;
}
#define WAIT_V0() asm volatile("s_waitcnt vmcnt(0)" ::: "memory")

template <int NT>
DEV void gemm_stage(const bf16* __restrict__ A, const bf16* __restrict__ Bt, int kt, char* sa, char* sb,
                    const unsigned (&ao)[4], const unsigned (&bo)[4], int wave) {
#pragma unroll
  for (int i = 0; i < 4; i++)
    __builtin_amdgcn_global_load_lds((const unsigned*)((const char*)A + (ao[i] + (unsigned)kt * 128u)),
                                     (unsigned*)(sa + wave * 1024 + i * 8192), 16, 0, 0);
#pragma unroll
  for (int i = 0; i < NT; i++)
    __builtin_amdgcn_global_load_lds((const unsigned*)((const char*)Bt + (bo[i] + (unsigned)kt * 128u)),
                                     (unsigned*)(sb + wave * 1024 + i * 8192), 16, 0, 0);
  __builtin_amdgcn_sched_barrier(0);
}
template <int NT, bool SWAP>
DEV void gemm_compute(f32x4 (&acc)[8][NT], const char* sa, const char* sb, const int (&aoff)[2], const int (&boff)[2]) {
#pragma unroll
  for (int ks = 0; ks < 2; ks++) {
    bf16x8 af[8], bv[NT];
#pragma unroll
    for (int j = 0; j < NT; j++) bv[j] = *(const bf16x8*)(sb + boff[ks] + j * 2048);
#pragma unroll
    for (int i = 0; i < 8; i++) af[i] = *(const bf16x8*)(sa + aoff[ks] + i * 2048);
    __builtin_amdgcn_s_setprio(1);
#pragma unroll
    for (int i = 0; i < 8; i++)
#pragma unroll
      for (int j = 0; j < NT; j++) acc[i][j] = SWAP ? mfma16(bv[j], af[i], acc[i][j]) : mfma16(af[i], bv[j], acc[i][j]);
    __builtin_amdgcn_s_setprio(0);
  }
  __builtin_amdgcn_sched_group_barrier(0x100, 8 + NT, 0);
  __builtin_amdgcn_sched_group_barrier(0x008, 8 * NT, 0);
  __builtin_amdgcn_sched_group_barrier(0x100, 8 + NT, 0);
  __builtin_amdgcn_sched_group_barrier(0x008, 8 * NT, 0);
  __builtin_amdgcn_sched_barrier(0);
}
struct Lds4 { char* a0; char* b0; char* a1; char* b1; };
template <int NT, bool SWAP = false>
DEV void gemm_loop8(f32x4 (&acc)[8][NT], const bf16* __restrict__ A, int lda, const bf16* __restrict__ Bt, int ldb, int K,
                    const Lds4& L) {
  const int tid = raw_tid(), lane = tid & 63, l16 = lane & 15, quad = lane >> 4;
  const int wave = __builtin_amdgcn_readfirstlane(tid >> 6);
  const int wm = wave >> 2, wn = wave & 3;
  unsigned ao[4], bo[4];
#pragma unroll
  for (int i = 0; i < 4; i++) {
    int r, c;
    stage_rc2(wave * 1024 + i * 8192 + lane * 16, r, c);
    ao[i] = (unsigned)(r * lda + c) * 2u;
    bo[i] = (unsigned)(r * ldb + c) * 2u;
  }
  int aoff[2], boff[2];
#pragma unroll
  for (int ks = 0; ks < 2; ks++) {
    aoff[ks] = lds_byte2(wm * 128 + l16, ks * 32 + quad * 8);
    boff[ks] = lds_byte2(wn * NT * 16 + l16, ks * 32 + quad * 8);
  }
  const int nk = K >> 6;
  gemm_stage<NT>(A, Bt, 0, L.a0, L.b0, ao, bo, wave);
  WAIT_V0();
  __syncthreads();
  for (int kt = 0; kt < nk; kt += 2) {
    gemm_stage<NT>(A, Bt, kt + 1, L.a1, L.b1, ao, bo, wave);
    gemm_compute<NT, SWAP>(acc, L.a0, L.b0, aoff, boff);
    WAIT_V0();
    __syncthreads();
    if (kt + 2 < nk) gemm_stage<NT>(A, Bt, kt + 2, L.a0, L.b0, ao, bo, wave);
    gemm_compute<NT, SWAP>(acc, L.a1, L.b1, aoff, boff);
    WAIT_V0();
    __syncthreads();
  }
}

template <int NT>
DEV void zero_acc(f32x4 (&acc)[8][NT]) {
#pragma unroll
  for (int i = 0; i < 8; i++)
#pragma unroll
    for (int j = 0; j < NT; j++) acc[i][j] = zero4();
}

DEV int xcd_compact_bid() {
  const int b = (int)blockIdx.x, n = (int)gridDim.x;
  return ((n & 7) == 0) ? (b & 7) * (n >> 3) + (b >> 3) : b;
}
DEV void phase_proj(const Params& p, int l, const Lds4& L) {
  const int tid = raw_tid(), lane = tid & 63;
  int l16 = lane & 15, quad = lane >> 4;
  const int wave = __builtin_amdgcn_readfirstlane(tid >> 6);
  const int wm = wave >> 2, wn = wave & 3;
  const bf16* H = (const bf16*)(p.ws + OFF_H);
  const bf16* WT = (const bf16*)wset(p, l);
  const float2* cs = (const float2*)(p.ws + OFF_CS);
  unsigned char* ws = p.ws;
  const int vbx = xcd_compact_bid();
  for (int tile = vbx; tile < 80 * 22; tile += gridDim.x) {
    const int mt = (tile / 88) * 4 + (tile & 3), nt = (tile % 88) >> 2;
    f32x4 acc[8][4];
    zero_acc<4>(acc);
    const int row0 = mt * 256 + wm * 128;
    const int cb = nt * 256 + wn * 64;
    const bool ctx = row0 < M_CTX;
    if (nt == 4 || nt == 5) {
      gemm_loop8<4, false>(acc, H + (size_t)mt * 256 * 1024, 1024, WT + (size_t)nt * 256 * 1024, 1024, 1024, L);
      asm volatile("" : "+v"(l16), "+v"(quad));
      const int c0 = cb - 1024, h = c0 >> 7, dv0 = c0 & 127;
#pragma unroll
      for (int i = 0; i < 8; i++) {
        const int tb = row0 + i * 16 + quad * 4;
#pragma unroll
        for (int j = 0; j < 4; j++) {
          const int dv = dv0 + j * 16 + l16;
          uint2 pk = make_uint2(pack2(acc[i][j][0], acc[i][j][1]), pack2(acc[i][j][2], acc[i][j][3]));
          if (ctx) {
            int b = tb >> 8, t = tb & 255;
            bf16* vt = (bf16*)(ws + OFF_VTC) + ((size_t)(b * 4 + h) * 128 + dv) * 256 + vperm(t);
            *(uint2*)vt = pk;
            float* o = p.out + OUT_V + ((size_t)(b * 4 + l) * 256 + t) * 512 + c0 + j * 16 + l16;
#pragma unroll
            for (int e = 0; e < 4; e++) o[(size_t)e * 512] = acc[i][j][e];
          } else {
            int r = tb - M_CTX, b = r >> 12, t = r & 4095;
            bf16* vt = (bf16*)(ws + OFF_VTL) + ((size_t)(b * 4 + h) * 128 + dv) * 4352 + vperm(t);
            *(uint2*)vt = pk;
          }
        }
      }
      continue;
    }
    gemm_loop8<4, true>(acc, H + (size_t)mt * 256 * 1024, 1024, WT + (size_t)nt * 256 * 1024, 1024, 1024, L);
    asm volatile("" : "+v"(l16), "+v"(quad));
    if (cb < 1024 || (cb >= 2048 && cb < 2560)) {
      const bool isA = cb < 1024;
      const bool isk = isA ? (cb >= 512) : (cb >= 2304);
      float4 wv[4];
#pragma unroll
      for (int j = 0; j < 4; j++) wv[j] = make_float4(1.f, 1.f, 1.f, 1.f);
      if (isA) {
        const float* qkw = p.in[12] + (l * 2 + (isk ? 1 : 0)) * 64 + quad * 4;
#pragma unroll
        for (int j = 0; j < 4; j++) wv[j] = *(const float4*)(qkw + j * 16);
      }
      bf16* dst;
      int dld, c0;
      if (isA) { dst = (bf16*)(ws + (isk ? OFF_KA : OFF_QA)); dld = 512; c0 = cb & 511; }
      else { dst = (bf16*)(ws + (isk ? OFF_BK : OFF_BQ)); dld = 256; c0 = (cb - 2048) & 255; }
      const float post = (isA && !isk) ? 0.18033688011112042f : ((!isA && isk) ? 0.125f : 1.f);
#pragma unroll
      for (int i = 0; i < 8; i++) {
        const int row = row0 + i * 16 + l16;
        float v[4][4];
#pragma unroll
        for (int j = 0; j < 4; j++)
#pragma unroll
          for (int e = 0; e < 4; e++) v[j][e] = acc[i][j][e];
        if (isA) {
          float ss = 0.f;
#pragma unroll
          for (int j = 0; j < 4; j++)
#pragma unroll
            for (int e = 0; e < 4; e++) ss += v[j][e] * v[j][e];
          ss += __shfl_xor(ss, 16);
          ss += __shfl_xor(ss, 32);
          const float rstd = rsqrtf(ss * (1.f / 64.f) + EPS);
#pragma unroll
          for (int j = 0; j < 4; j++) {
            v[j][0] *= rstd * wv[j].x; v[j][1] *= rstd * wv[j].y; v[j][2] *= rstd * wv[j].z; v[j][3] *= rstd * wv[j].w;
          }
          if (isk && ctx) {
            int b = row >> 8, t = row & 255;
            float* o = p.out + OUT_K + ((size_t)(b * 4 + l) * 256 + t) * 512 + c0 + quad * 4;
#pragma unroll
            for (int j = 0; j < 4; j++) *(float4*)(o + j * 16) = make_float4(v[j][0], v[j][1], v[j][2], v[j][3]);
          }
        }
        if (!ctx) {
          const int t = (row - M_CTX) & 4095;
          const float2* cr = cs + (t >> 6) * 16 + quad * 4;
          const float2* cc = cs + (t & 63) * 16 + quad * 4;
#pragma unroll
          for (int e = 0; e < 4; e++) {
            const float2 r2 = cr[e], c2 = cc[e];
            const float y0 = v[0][e] * r2.x - v[1][e] * r2.y, y1 = v[1][e] * r2.x + v[0][e] * r2.y;
            const float y2 = v[2][e] * c2.x - v[3][e] * c2.y, y3 = v[3][e] * c2.x + v[2][e] * c2.y;
            v[0][e] = y0; v[1][e] = y1; v[2][e] = y2; v[3][e] = y3;
          }
        }
        bf16* d = dst + (size_t)row * dld + c0 + quad * 4;
#pragma unroll
        for (int j = 0; j < 4; j++)
          *(uint2*)(d + j * 16) = make_uint2(pack2(v[j][0] * post, v[j][1] * post), pack2(v[j][2] * post, v[j][3] * post));
      }
    } else {
      bf16* dst; int c0; bool act = false;
      if (cb < 2048) { dst = (bf16*)(ws + OFF_AZ); c0 = cb - 1536; act = true; }
      else if (cb < 3072) { dst = (bf16*)(ws + OFF_BV); c0 = cb - 2560; }
      else if (cb < 3584) { dst = (bf16*)(ws + OFF_BZ); c0 = cb - 3072; act = true; }
      else if (cb < 4096) { dst = (bf16*)(ws + OFF_CQ); c0 = cb - 3584; }
      else if (cb < 4608) { dst = (bf16*)(ws + OFF_CK); c0 = cb - 4096; }
      else if (cb < 5120) { dst = (bf16*)(ws + OFF_CV); c0 = cb - 4608; }
      else { dst = (bf16*)(ws + OFF_CZ); c0 = cb - 5120; act = true; }
#pragma unroll
      for (int i = 0; i < 8; i++) {
        bf16* d = dst + (size_t)(row0 + i * 16 + l16) * 512 + c0 + quad * 4;
#pragma unroll
        for (int j = 0; j < 4; j++) {
          float v0 = acc[i][j][0], v1 = acc[i][j][1], v2 = acc[i][j][2], v3 = acc[i][j][3];
          if (act) { v0 = silu(v0); v1 = silu(v1); v2 = silu(v2); v3 = silu(v3); }
          *(uint2*)(d + j * 16) = make_uint2(pack2(v0, v1), pack2(v2, v3));
        }
      }
    }
  }
  const int nbk = (int)gridDim.x, firstb = nbk > 32 ? nbk - 32 : 0;
  if (vbx >= firstb) {
    for (int mt = vbx - firstb; mt < 80; mt += nbk - firstb) {
      f32x4 acc[8][1];
      zero_acc<1>(acc);
      gemm_loop8<1>(acc, H + (size_t)mt * 256 * 1024, 1024, WT + (size_t)5632 * 1024, 1024, 1024, L);
      asm volatile("" : "+v"(l16), "+v"(quad));
      if (wn == 0) {
        float* ba = (float*)(ws + OFF_BA);
        const int row0 = mt * 256 + wm * 128;
#pragma unroll
        for (int i = 0; i < 8; i++)
#pragma unroll
          for (int e = 0; e < 4; e++) ba[(size_t)(row0 + i * 16 + quad * 4 + e) * 16 + l16] = acc[i][0][e];
      }
    }
  }
}

DEV float log_sigmoid(float x) { return x < 0.f ? x - log1pf(expf(x)) : -log1pf(expf(-x)); }

DEV void ret_prep_item(const Params& p, int l, int item, bf16* sm) {
  const int tid = opaque_tid(), lane = tid & 63, wave = tid >> 6, l16 = lane & 15, quad = lane >> 4;
  const int c = item >> 2, h = item & 3;
  bf16* sKT0 = sm;
  bf16* sKT1 = sm + 4608;
  bf16* sVT = sm + 9216;
  const float lgf = log_sigmoid(p.in[15][l * 8 + h]);
  const float lgb = log_sigmoid(p.in[15][l * 8 + 4 + h]);
  const bf16* BK = (const bf16*)(p.ws + OFF_BK);
  const bf16* BV = (const bf16*)(p.ws + OFF_BV);
  const int r0 = c * 64;
  {
    int t = tid >> 2, dq = (tid & 3) * 16;
    float df = __expf(lgf * (float)(63 - t)), db = __expf(lgb * (float)t);
    const bf16* src = BK + (size_t)(r0 + t) * 256 + h * 64 + dq;
    U8 a, b;
    a.u = *(const uint4*)src; b.u = *(const uint4*)(src + 8);
#pragma unroll
    for (int i = 0; i < 4; i++) {
      float x0 = lo2f(a.w[i]), x1 = hi2f(a.w[i]), x2 = lo2f(b.w[i]), x3 = hi2f(b.w[i]);
      sKT0[(dq + 2 * i) * 72 + t] = f2bf(x0 * df); sKT0[(dq + 2 * i + 1) * 72 + t] = f2bf(x1 * df);
      sKT0[(dq + 8 + 2 * i) * 72 + t] = f2bf(x2 * df); sKT0[(dq + 8 + 2 * i + 1) * 72 + t] = f2bf(x3 * df);
      sKT1[(dq + 2 * i) * 72 + t] = f2bf(x0 * db); sKT1[(dq + 2 * i + 1) * 72 + t] = f2bf(x1 * db);
      sKT1[(dq + 8 + 2 * i) * 72 + t] = f2bf(x2 * db); sKT1[(dq + 8 + 2 * i + 1) * 72 + t] = f2bf(x3 * db);
    }
    int dvq = (tid & 3) * 32;
    const bf16* sv = BV + (size_t)(r0 + t) * 512 + h * 128 + dvq;
#pragma unroll
    for (int g = 0; g < 4; g++) {
      U8 x; x.u = *(const uint4*)(sv + g * 8);
#pragma unroll
      for (int i = 0; i < 4; i++) {
        sVT[(dvq + g * 8 + 2 * i) * 72 + t] = (bf16)(x.w[i] & 0xffffu);
        sVT[(dvq + g * 8 + 2 * i + 1) * 72 + t] = (bf16)(x.w[i] >> 16);
      }
    }
  }
  __syncthreads();
  {
    const int d = wave & 1, rt0 = (wave >> 1) * 2;
    const bf16* sKT = d ? sKT1 : sKT0;
    bf16* RU = (bf16*)(p.ws + OFF_RU) + ((size_t)(c * 4 + h) * 2 + d) * 8192;
#pragma unroll
    for (int ri = 0; ri < 2; ri++) {
      const int rt = rt0 + ri;
      bf16x8 a0 = *(const bf16x8*)(sKT + (rt * 16 + l16) * 72 + quad * 8);
      bf16x8 a1 = *(const bf16x8*)(sKT + (rt * 16 + l16) * 72 + 32 + quad * 8);
#pragma unroll
      for (int j = 0; j < 8; j++) {
        f32x4 acc = zero4();
        bf16x8 b0 = *(const bf16x8*)(sVT + (j * 16 + l16) * 72 + quad * 8);
        bf16x8 b1 = *(const bf16x8*)(sVT + (j * 16 + l16) * 72 + 32 + quad * 8);
        acc = mfma16(a0, b0, acc);
        acc = mfma16(a1, b1, acc);
        uint2 pk = make_uint2(pack2(acc[0], acc[1]), pack2(acc[2], acc[3]));
        *(uint2*)(RU + (j * 16 + l16) * 64 + rt * 16 + quad * 4) = pk;
      }
    }
  }
  __syncthreads();
}

DEV void ret_scan_item(const Params& p, int l, int item) {
  const int tid = opaque_tid();
  const int part = item & 3, chain = item >> 2;
  bool lat; int b, h, d;
  if (chain < 32) { lat = true; b = chain >> 3; h = (chain >> 1) & 3; d = chain & 1; }
  else { int cc = chain - 32; lat = false; b = cc >> 3; h = (cc >> 1) & 3; d = cc & 1; }
  const int N = lat ? 64 : 4;
  const int cbase = lat ? 64 + b * 64 : b * 4;
  const int idx = part * 2048 + tid * 8;
  const int dv = idx >> 6, dk0 = idx & 63;
  const float lg = log_sigmoid(p.in[15][l * 8 + d * 4 + h]);
  const float cdec = __expf(64.f * lg);
  float S[8];
  if (lat) {
    const float* s0 = p.in[4] + ((size_t)((b * 4 + l) * 2 + d) * 4 + h) * 8192;
#pragma unroll
    for (int i = 0; i < 8; i++) S[i] = s0[(dk0 + i) * 128 + dv];
  } else {
#pragma unroll
    for (int i = 0; i < 8; i++) S[i] = 0.f;
  }
  bf16* RU = (bf16*)(p.ws + OFF_RU);
  for (int n0 = 0; n0 < N; n0 += 4) {
    bf16* ptr[4];
    U8 u[4];
#pragma unroll
    for (int k = 0; k < 4; k++) {
      const int n = n0 + k;
      const int c = cbase + (d == 0 ? n : N - 1 - n);
      ptr[k] = RU + ((size_t)(c * 4 + h) * 2 + d) * 8192 + idx;
      u[k].u = *(const uint4*)ptr[k];
    }
#pragma unroll
    for (int k = 0; k < 4; k++) {
      U8 o;
#pragma unroll
      for (int i = 0; i < 4; i++) o.w[i] = pack2(S[2 * i], S[2 * i + 1]);
      *(uint4*)ptr[k] = o.u;
#pragma unroll
      for (int i = 0; i < 4; i++) {
        S[2 * i] = S[2 * i] * cdec + lo2f(u[k].w[i]);
        S[2 * i + 1] = S[2 * i + 1] * cdec + hi2f(u[k].w[i]);
      }
    }
  }
  if (!lat) {
    float* o = p.out + OUT_RET + ((size_t)((b * 4 + l) * 2 + d) * 4 + h) * 8192;
#pragma unroll
    for (int i = 0; i < 8; i++) o[(dk0 + i) * 128 + dv] = S[i];
  }
}

DEV void ret_post_item(const Params& p, int l, int item, bf16* sm, bf16* smB, int dry) {
  const int tid = opaque_tid(), lane = tid & 63, wave = tid >> 6, l16 = lane & 15, quad = lane >> 4;
  const int c = item >> 2, h = item & 3;
  bf16* sQ = sm;
  bf16* sWm = sm + 4608;
  bf16* sVT = sm + 9216;
  bf16* sK = sVT;
  bf16* sSf = smB;
  bf16* sSb = smB + 9216;
  const float lgf = log_sigmoid(p.in[15][l * 8 + h]);
  const float lgb = log_sigmoid(p.in[15][l * 8 + 4 + h]);
  const bf16* BQ = (const bf16*)(p.ws + OFF_BQ);
  const bf16* BK = (const bf16*)(p.ws + OFF_BK);
  bf16* BV = (bf16*)(p.ws + OFF_BV);
  const bf16* BZ = (const bf16*)(p.ws + OFF_BZ);
  const bf16* RU = (const bf16*)(p.ws + OFF_RU) + (size_t)(c * 4 + h) * 2 * 8192;
  const int r0 = c * 64;
  for (int ch = tid; ch < 1024; ch += 256) {
    int which = ch >> 9, cc = ch & 511, t = cc >> 3, k8 = (cc & 7) * 8;
    const bf16* src = (which ? BK : BQ) + (size_t)(r0 + t) * 256 + h * 64 + k8;
    *(uint4*)((which ? sK : sQ) + t * 72 + k8) = *(const uint4*)src;
  }
  for (int ch = tid; ch < 2048; ch += 256) {
    int which = ch >> 10, cc = ch & 1023, dv = cc >> 3, k8 = (cc & 7) * 8;
    *(uint4*)((which ? sSb : sSf) + dv * 72 + k8) = *(const uint4*)(RU + which * 8192 + dv * 64 + k8);
  }
  __syncthreads();
  {
    bf16x8 a0 = *(const bf16x8*)(sQ + (wave * 16 + l16) * 72 + quad * 8);
    bf16x8 a1 = *(const bf16x8*)(sQ + (wave * 16 + l16) * 72 + 32 + quad * 8);
    f32x4 qk[4];
#pragma unroll
    for (int j = 0; j < 4; j++) {
      qk[j] = zero4();
      bf16x8 b0 = *(const bf16x8*)(sK + (j * 16 + l16) * 72 + quad * 8);
      bf16x8 b1 = *(const bf16x8*)(sK + (j * 16 + l16) * 72 + 32 + quad * 8);
      qk[j] = mfma16(a0, b0, qk[j]);
      qk[j] = mfma16(a1, b1, qk[j]);
    }
#pragma unroll
    for (int j = 0; j < 4; j++)
#pragma unroll
      for (int e = 0; e < 4; e++) {
        int t = wave * 16 + quad * 4 + e, t2 = j * 16 + l16;
        float f = 0.f;
        if (t >= t2) f += __expf(lgf * (float)(t - t2));
        if (t2 >= t) f += __expf(lgb * (float)(t2 - t));
        sWm[t * 72 + t2] = f2bf(qk[j][e] * f);
      }
  }
  __syncthreads();
  {
    int t = tid >> 2, dvq = (tid & 3) * 32;
    const bf16* sv = BV + (size_t)(r0 + t) * 512 + h * 128 + dvq;
#pragma unroll
    for (int g = 0; g < 4; g++) {
      U8 x; x.u = *(const uint4*)(sv + g * 8);
#pragma unroll
      for (int i = 0; i < 4; i++) {
        sVT[(dvq + g * 8 + 2 * i) * 72 + t] = (bf16)(x.w[i] & 0xffffu);
        sVT[(dvq + g * 8 + 2 * i + 1) * 72 + t] = (bf16)(x.w[i] >> 16);
      }
    }
  }
  __syncthreads();
  {
    bf16x8 aw0 = *(const bf16x8*)(sWm + (wave * 16 + l16) * 72 + quad * 8);
    bf16x8 aw1 = *(const bf16x8*)(sWm + (wave * 16 + l16) * 72 + 32 + quad * 8);
    bf16x8 aq0 = *(const bf16x8*)(sQ + (wave * 16 + l16) * 72 + quad * 8);
    bf16x8 aq1 = *(const bf16x8*)(sQ + (wave * 16 + l16) * 72 + 32 + quad * 8);
    float rf[4], rb[4];
#pragma unroll
    for (int e = 0; e < 4; e++) {
      int t = wave * 16 + quad * 4 + e;
      rf[e] = __expf(lgf * (float)(t + 1));
      rb[e] = __expf(lgb * (float)(64 - t));
    }
    f32x4 o[8];
    float ss[4] = {0.f, 0.f, 0.f, 0.f};
#pragma unroll
    for (int j = 0; j < 8; j++) {
      const int bo = (j * 16 + l16) * 72 + quad * 8;
      f32x4 a1 = zero4(), a2 = zero4(), a3 = zero4();
      a1 = mfma16(aw0, *(const bf16x8*)(sVT + bo), a1);
      a1 = mfma16(aw1, *(const bf16x8*)(sVT + bo + 32), a1);
      a2 = mfma16(aq0, *(const bf16x8*)(sSf + bo), a2);
      a2 = mfma16(aq1, *(const bf16x8*)(sSf + bo + 32), a2);
      a3 = mfma16(aq0, *(const bf16x8*)(sSb + bo), a3);
      a3 = mfma16(aq1, *(const bf16x8*)(sSb + bo + 32), a3);
#pragma unroll
      for (int e = 0; e < 4; e++) {
        float v = a1[e] + rf[e] * a2[e] + rb[e] * a3[e];
        o[j][e] = v;
        ss[e] += v * v;
      }
    }
#pragma unroll
    for (int e = 0; e < 4; e++) {
      float s = ss[e];
      s += __shfl_xor(s, 1); s += __shfl_xor(s, 2); s += __shfl_xor(s, 4); s += __shfl_xor(s, 8);
      ss[e] = rsqrtf(s * (1.f / 128.f) + EPS);
    }
    const float* nw = p.in[16] + l * 128;
#pragma unroll
    for (int j = 0; j < 8; j++) {
      float w = nw[j * 16 + l16];
#pragma unroll
      for (int e = 0; e < 4; e++) {
        int row = r0 + wave * 16 + quad * 4 + e;
        size_t off = (size_t)row * 512 + h * 128 + j * 16 + l16;
        float z = bf2f(BZ[off]);
        if (!dry) BV[off] = f2bf(o[j][e] * ss[e] * w * z);
      }
    }
  }
  __syncthreads();
}

template <bool UPPER>
DEV void solve_tri(float* T, int lane) {
#pragma unroll 1
  for (int blk = 0; blk < 8; blk++) {
    float t[64];
#pragma unroll
    for (int j = 0; j < 64; j++) t[j] = T[j * 68 + lane];
    float tb[8], v[8];
#pragma unroll
    for (int jj = 0; jj < 8; jj++) {
      const int j = UPPER ? 63 - (blk * 8 + jj) : blk * 8 + jj;
      tb[jj] = T[j * 68 + lane];
    }
#pragma unroll
    for (int rr = 0; rr < 8; rr++) {
      const int r = UPPER ? 63 - (blk * 8 + rr) : blk * 8 + rr;
      float4 a[16];
#pragma unroll
      for (int q = 0; q < 16; q++) a[q] = *(const float4*)(T + r * 68 + q * 4);
      float s0 = 0.f, s1 = 0.f, s2 = 0.f, s3 = 0.f;
#pragma unroll
      for (int q = 0; q < 16; q++) {
        s0 = fmaf(a[q].x, t[4 * q + 0], s0);
        s1 = fmaf(a[q].y, t[4 * q + 1], s1);
        s2 = fmaf(a[q].z, t[4 * q + 2], s2);
        s3 = fmaf(a[q].w, t[4 * q + 3], s3);
      }
      float s = (s0 + s1) + (s2 + s3);
#pragma unroll
      for (int jj = 0; jj < rr; jj++) {
        const int j = UPPER ? 63 - (blk * 8 + jj) : blk * 8 + jj;
        s = fmaf(T[r * 68 + j], v[jj] - tb[jj], s);
      }
      v[rr] = (r == lane ? 1.f : 0.f) - s;
    }
    __builtin_amdgcn_wave_barrier();
#pragma unroll
    for (int rr = 0; rr < 8; rr++) {
      const int r = UPPER ? 63 - (blk * 8 + rr) : blk * 8 + rr;
      T[r * 68 + lane] = v[rr];
    }
    __builtin_amdgcn_wave_barrier();
  }
}

DEV void gdn_prep_item(const Params& p, int l, int item, bf16* sm, bf16* smB) {
  const int tid = opaque_tid(), lane = tid & 63, wave = tid >> 6, l16 = lane & 15, quad = lane >> 4;
  const int c = item >> 2, h = item & 3;
  bf16* sQ = sm;
  bf16* sK = sm + 8704;
  bf16* sKT = smB;
  bf16* sVT = smB + 9216;
  float* sBeta = (float*)(sm + 17408);
  float* sGc = sBeta + 128;
  float* T0 = (float*)sQ;
  float* T1 = (float*)sK;
  const int r0 = c * 64;
  int seq_lo, seq_hi;
  if (c < 64) { seq_lo = (c >> 2) * 256; seq_hi = seq_lo + 256; }
  else { seq_lo = M_CTX + ((c - 64) >> 6) * 4096; seq_hi = seq_lo + 4096; }
  {
    const int cc = tid & 15, rg = tid >> 4;
    const int gr = r0 + rg * 4;
    bf16* CQ2 = (bf16*)(p.ws + OFF_CQ2);
    bf16* CK2 = (bf16*)(p.ws + OFF_CK2);
    typedef unsigned int u32x4 __attribute__((ext_vector_type(4)));
    u32x4 xp[8];
    auto conv_load = [&](int seg) __attribute__((always_inline)) {
      const bf16* src = (const bf16*)(p.ws + (seg == 0 ? OFF_CQ : (seg == 1 ? OFF_CK : OFF_CV))) + h * 128 + cc * 8;
#pragma unroll
      for (int r = 0; r < 8; r++) {
        const int rr = gr + r - 2;
        const u32x4 zz = {0u, 0u, 0u, 0u};
        xp[r] = (rr >= seq_lo && rr < seq_hi) ? *(const u32x4*)(src + (size_t)rr * 512) : zz;
      }
    };
    conv_load(0);
#pragma unroll 1
    for (int seg = 0; seg < 3; seg++) {
      const float* cw = p.in[17] + (size_t)l * 5 * 1536 + seg * 512 + h * 128 + cc * 8;
      U8 x[8];
#pragma unroll
      for (int r = 0; r < 8; r++) { x[r].w[0] = xp[r][0]; x[r].w[1] = xp[r][1]; x[r].w[2] = xp[r][2]; x[r].w[3] = xp[r][3]; }
      conv_load(seg < 2 ? seg + 1 : 2);
      float o[4][8];
#pragma unroll
      for (int r = 0; r < 4; r++)
#pragma unroll
        for (int i = 0; i < 8; i++) o[r][i] = 0.f;
#pragma unroll
      for (int j = 0; j < 5; j++) {
        const float4 w0 = *(const float4*)(cw + j * 1536), w1 = *(const float4*)(cw + j * 1536 + 4);
#pragma unroll
        for (int r = 0; r < 4; r++) {
          o[r][0] += lo2f(x[r + j].w[0]) * w0.x; o[r][1] += hi2f(x[r + j].w[0]) * w0.y;
          o[r][2] += lo2f(x[r + j].w[1]) * w0.z; o[r][3] += hi2f(x[r + j].w[1]) * w0.w;
          o[r][4] += lo2f(x[r + j].w[2]) * w1.x; o[r][5] += hi2f(x[r + j].w[2]) * w1.y;
          o[r][6] += lo2f(x[r + j].w[3]) * w1.z; o[r][7] += hi2f(x[r + j].w[3]) * w1.w;
        }
      }
      U8 pk[4];
#pragma unroll
      for (int r = 0; r < 4; r++) {
        float ss = 0.f;
#pragma unroll
        for (int i = 0; i < 8; i++) { o[r][i] = silu(o[r][i]); ss += o[r][i] * o[r][i]; }
        float rn = 1.f;
        if (seg < 2) {
          ss += __shfl_xor(ss, 1); ss += __shfl_xor(ss, 2); ss += __shfl_xor(ss, 4); ss += __shfl_xor(ss, 8);
          rn = rsqrtf(ss + EPS);
        }
#pragma unroll
        for (int i = 0; i < 4; i++) pk[r].w[i] = pack2(o[r][2 * i] * rn, o[r][2 * i + 1] * rn);
      }
      if (seg < 2) {
        bf16* sd = seg == 0 ? sQ : sK;
        bf16* gd = (seg == 0 ? CQ2 : CK2) + (size_t)gr * 512 + h * 128 + cc * 8;
#pragma unroll
        for (int r = 0; r < 4; r++) {
          *(uint4*)(sd + (rg * 4 + r) * 136 + cc * 8) = pk[r].u;
          *(uint4*)(gd + (size_t)r * 512) = pk[r].u;
        }
      }
      if (seg >= 1) {
        bf16* st = seg == 1 ? sKT : sVT;
#pragma unroll
        for (int i = 0; i < 4; i++) {
          uint2 lo = make_uint2((pk[0].w[i] & 0xffffu) | (pk[1].w[i] << 16), (pk[2].w[i] & 0xffffu) | (pk[3].w[i] << 16));
          uint2 hi = make_uint2((pk[0].w[i] >> 16) | (pk[1].w[i] & 0xffff0000u), (pk[2].w[i] >> 16) | (pk[3].w[i] & 0xffff0000u));
          *(uint2*)(st + (cc * 8 + 2 * i) * 72 + rg * 4) = lo;
          *(uint2*)(st + (cc * 8 + 2 * i + 1) * 72 + rg * 4) = hi;
        }
      }
    }
  }
  if (tid < 128) {
    const int d = tid >> 6, t = tid & 63;
    const float* ba = (const float*)(p.ws + OFF_BA) + (size_t)(r0 + t) * 16;
    float bl = ba[d * 4 + h], al = ba[8 + d * 4 + h];
    float beta = sigm(bl);
    float x = al + p.in[19][l * 8 + d * 4 + h];
    float sp = x > 20.f ? x : log1pf(expf(x));
    float g = -expf(p.in[18][l * 8 + d * 4 + h]) * sp;
    if (d == 0) {
#pragma unroll
      for (int o = 1; o < 64; o <<= 1) { float v = __shfl_up(g, o); if (t >= o) g += v; }
    } else {
#pragma unroll
      for (int o = 1; o < 64; o <<= 1) { float v = __shfl_down(g, o); if (t + o < 64) g += v; }
    }
    sBeta[d * 64 + t] = beta;
    sGc[d * 64 + t] = g;
    ((float*)(p.ws + OFF_GC))[((size_t)(c * 4 + h) * 2 + d) * 64 + t] = g;
  }
  __syncthreads();
  f32x4 G[4], QK[4];
  {
#pragma unroll
    for (int j = 0; j < 4; j++) { G[j] = zero4(); QK[j] = zero4(); }
#pragma unroll
    for (int ks = 0; ks < 4; ks++) {
      bf16x8 ak = *(const bf16x8*)(sK + (wave * 16 + l16) * 136 + ks * 32 + quad * 8);
      bf16x8 aq = *(const bf16x8*)(sQ + (wave * 16 + l16) * 136 + ks * 32 + quad * 8);
#pragma unroll
      for (int j = 0; j < 4; j++) {
        bf16x8 bk = *(const bf16x8*)(sK + (j * 16 + l16) * 136 + ks * 32 + quad * 8);
        G[j] = mfma16(ak, bk, G[j]);
        QK[j] = mfma16(aq, bk, QK[j]);
      }
    }
  }
  __syncthreads();
  {
    bf16* QKD = (bf16*)(p.ws + OFF_QKD) + (size_t)(c * 4 + h) * 2 * 4096;
    const float scale = 0.08838834764831845f;
    float gcf_t[4], gcb_t[4], bf_t[4], bb_t[4];
#pragma unroll
    for (int e = 0; e < 4; e++) {
      const int t = wave * 16 + quad * 4 + e;
      gcf_t[e] = sGc[t]; gcb_t[e] = sGc[64 + t]; bf_t[e] = sBeta[t]; bb_t[e] = sBeta[64 + t];
    }
#pragma unroll
    for (int j = 0; j < 4; j++) {
      const int t2 = j * 16 + l16;
      const float gcf2 = sGc[t2], gcb2 = sGc[64 + t2];
#pragma unroll
      for (int e = 0; e < 4; e++) {
        const int t = wave * 16 + quad * 4 + e;
        const float ef = __expf(fminf(gcf_t[e] - gcf2, 0.f)), eb = __expf(fminf(gcb_t[e] - gcb2, 0.f));
        const float a0 = bf_t[e] * G[j][e] * ef, a1 = bb_t[e] * G[j][e] * eb;
        const float q0 = QK[j][e] * scale * ef, q1 = QK[j][e] * scale * eb;
        T0[t * 68 + t2] = (t2 < t) ? a0 : 0.f;
        T1[t * 68 + t2] = (t2 > t) ? a1 : 0.f;
        QKD[t * 64 + t2] = f2bf((t2 <= t) ? q0 : 0.f);
        QKD[4096 + t * 64 + t2] = f2bf((t2 >= t) ? q1 : 0.f);
      }
    }
  }
  __syncthreads();
  if (wave == 0) solve_tri<false>(T0, lane);
  else if (wave == 1) solve_tri<true>(T1, lane);
  __syncthreads();
  {
    bf16* U = (bf16*)(p.ws + OFF_U);
    bf16* W = (bf16*)(p.ws + OFF_W);
#pragma unroll 1
    for (int d = 0; d < 2; d++) {
      const float* T = d ? T1 : T0;
      bf16x8 au[2], aw[2];
#pragma unroll
      for (int ks = 0; ks < 2; ks++) {
        const int kk = ks * 32 + quad * 8;
        const float* tr = T + (wave * 16 + l16) * 68 + kk;
        float4 t0 = *(const float4*)tr, t1 = *(const float4*)(tr + 4);
        float tv[8] = {t0.x, t0.y, t0.z, t0.w, t1.x, t1.y, t1.z, t1.w};
        U8 pu, pw;
#pragma unroll
        for (int i = 0; i < 4; i++) {
          float b0 = sBeta[d * 64 + kk + 2 * i], b1 = sBeta[d * 64 + kk + 2 * i + 1];
          float e0 = __expf(sGc[d * 64 + kk + 2 * i]), e1 = __expf(sGc[d * 64 + kk + 2 * i + 1]);
          pu.w[i] = pack2(tv[2 * i] * b0, tv[2 * i + 1] * b1);
          pw.w[i] = pack2(tv[2 * i] * b0 * e0, tv[2 * i + 1] * b1 * e1);
        }
        au[ks] = pu.v; aw[ks] = pw.v;
      }
#pragma unroll 2
      for (int j = 0; j < 8; j++) {
        f32x4 a1 = zero4(), a2 = zero4();
#pragma unroll
        for (int ks = 0; ks < 2; ks++) {
          a1 = mfma16(*(const bf16x8*)(sVT + (j * 16 + l16) * 72 + ks * 32 + quad * 8), au[ks], a1);
          a2 = mfma16(*(const bf16x8*)(sKT + (j * 16 + l16) * 72 + ks * 32 + quad * 8), aw[ks], a2);
        }
        const int row = r0 + wave * 16 + l16;
        const size_t off = (size_t)d * M_TOT * 512 + (size_t)row * 512 + h * 128 + j * 16 + quad * 4;
        *(uint2*)(U + off) = make_uint2(pack2(a1[0], a1[1]), pack2(a1[2], a1[3]));
        *(uint2*)(W + off) = make_uint2(pack2(a2[0], a2[1]), pack2(a2[2], a2[3]));
      }
    }
  }
  __syncthreads();
}

DEV void gdn_chain_item(const Params& p, int l, int item, bf16* sm, bf16* smB) {
  const int tid = opaque_tid(), lane = tid & 63, wave = tid >> 6, l16 = lane & 15, quad = lane >> 4;
  const int s = item & 3, chain = item >> 2;
  bool lat; int b, h, d;
  if (chain < 32) { lat = true; b = chain >> 3; h = (chain >> 1) & 3; d = chain & 1; }
  else { int cc = chain - 32; lat = false; b = cc >> 3; h = (cc >> 1) & 3; d = cc & 1; }
  const int N = lat ? 64 : 4;
  const int cbase = lat ? 64 + b * 64 : b * 4;
  bf16* sW = sm;
  bf16* sQ = sm + 8704;
  bf16* sVN = sm + 17408;
  bf16* sKT = smB;
  bf16* sQK = smB + 9216;
  bf16* sST = smB + 13824;
  const bf16* Wg = (const bf16*)(p.ws + OFF_W) + (size_t)d * M_TOT * 512;
  const bf16* Ug = (const bf16*)(p.ws + OFF_U) + (size_t)d * M_TOT * 512;
  const bf16* CQ2 = (const bf16*)(p.ws + OFF_CQ2);
  const bf16* CK2 = (const bf16*)(p.ws + OFF_CK2);
  bf16* OD = (bf16*)(p.ws + (d ? OFF_CK : OFF_CQ));
  const float* GC = (const float*)(p.ws + OFF_GC);
  const bf16* QKDg = (const bf16*)(p.ws + OFF_QKD);
  const float scale = 0.08838834764831845f;
  f32x4 S[2][2];
  if (lat) {
    const float* s0 = p.in[5] + ((size_t)((b * 4 + l) * 2 + d) * 4 + h) * 16384;
#pragma unroll
    for (int i = 0; i < 2; i++)
#pragma unroll
      for (int j = 0; j < 2; j++)
#pragma unroll
        for (int e = 0; e < 4; e++) S[i][j][e] = s0[((2 * wave + i) * 16 + quad * 4 + e) * 128 + s * 32 + j * 16 + l16];
  } else {
#pragma unroll
    for (int i = 0; i < 2; i++)
#pragma unroll
      for (int j = 0; j < 2; j++) S[i][j] = zero4();
  }
  typedef unsigned int u32x4 __attribute__((ext_vector_type(4)));
  u32x4 rw[4], rq[4], rk[4], rqk[2];
  float rgt[4], rgl = 0.f;
  float ruu[2][4];
  auto chain_load = [&](int n) __attribute__((always_inline)) {
    const int c = cbase + (d == 0 ? n : N - 1 - n);
    const int r0 = c * 64;
    const float* gc = GC + ((size_t)(c * 4 + h) * 2 + d) * 64;
    rgl = d == 0 ? gc[63] : gc[0];
#pragma unroll
    for (int i = 0; i < 4; i++) {
      const int t = (tid >> 4) * 4 + i, k8 = (tid & 15) * 8;
      const size_t go = (size_t)(r0 + t) * 512 + h * 128 + k8;
      rw[i] = *(const u32x4*)(Wg + go);
      rq[i] = *(const u32x4*)(CQ2 + go);
      rk[i] = *(const u32x4*)(CK2 + go);
      rgt[i] = gc[t];
    }
#pragma unroll
    for (int i = 0; i < 2; i++) {
      const int ch = tid + 256 * i, t = ch >> 3, k8 = (ch & 7) * 8;
      rqk[i] = *(const u32x4*)(QKDg + ((size_t)(c * 4 + h) * 2 + d) * 4096 + t * 64 + k8);
    }
#pragma unroll
    for (int j = 0; j < 2; j++)
#pragma unroll
      for (int e = 0; e < 4; e++)
        ruu[j][e] = bf2f(Ug[(size_t)(r0 + wave * 16 + quad * 4 + e) * 512 + h * 128 + s * 32 + j * 16 + l16]);
  };
  chain_load(0);
  for (int n = 0; n < N; n++) {
    const int c = cbase + (d == 0 ? n : N - 1 - n);
    const int r0 = c * 64;
    const float glast = rgl;
#pragma unroll
    for (int i = 0; i < 2; i++)
#pragma unroll
      for (int j = 0; j < 2; j++) {
        uint2 pk = make_uint2(pack2(S[i][j][0], S[i][j][1]), pack2(S[i][j][2], S[i][j][3]));
        *(uint2*)(sST + (j * 16 + l16) * 136 + (2 * wave + i) * 16 + quad * 4) = pk;
      }
    {
      const int tg = tid >> 4, k8 = (tid & 15) * 8;
      float ksf[4];
#pragma unroll
      for (int i = 0; i < 4; i++) {
        const int t = tg * 4 + i;
        *(u32x4*)(sW + t * 136 + k8) = rw[i];
        const float gt = rgt[i];
        const float qs = scale * __expf(gt);
        ksf[i] = __expf(glast - gt);
        u32x4 qo;
#pragma unroll
        for (int w2 = 0; w2 < 4; w2++) qo[w2] = pack2(lo2f(rq[i][w2]) * qs, hi2f(rq[i][w2]) * qs);
        *(u32x4*)(sQ + t * 136 + k8) = qo;
      }
      const int gsw = ((tg >> 1) ^ ((tid & 15) & 7)) * 8 + (tg & 1) * 4;
#pragma unroll
      for (int w2 = 0; w2 < 4; w2++) {
        const uint2 lo = make_uint2(pack2(lo2f(rk[0][w2]) * ksf[0], lo2f(rk[1][w2]) * ksf[1]),
                                    pack2(lo2f(rk[2][w2]) * ksf[2], lo2f(rk[3][w2]) * ksf[3]));
        const uint2 hi = make_uint2(pack2(hi2f(rk[0][w2]) * ksf[0], hi2f(rk[1][w2]) * ksf[1]),
                                    pack2(hi2f(rk[2][w2]) * ksf[2], hi2f(rk[3][w2]) * ksf[3]));
        *(uint2*)(sKT + (k8 + 2 * w2) * 72 + gsw) = lo;
        *(uint2*)(sKT + (k8 + 2 * w2 + 1) * 72 + gsw) = hi;
      }
    }
#pragma unroll
    for (int i = 0; i < 2; i++) {
      const int ch = tid + 256 * i, t = ch >> 3, k8 = (ch & 7) * 8;
      *(u32x4*)(sQK + t * 72 + k8) = rqk[i];
    }
    float uu[2][4];
#pragma unroll
    for (int j = 0; j < 2; j++)
#pragma unroll
      for (int e = 0; e < 4; e++) uu[j][e] = ruu[j][e];
    chain_load(n + 1 < N ? n + 1 : n);
    __builtin_amdgcn_sched_barrier(0);
    __syncthreads();
    f32x4 vn[2];
    {
      vn[0] = zero4(); vn[1] = zero4();
#pragma unroll
      for (int ks = 0; ks < 4; ks++) {
        bf16x8 a = *(const bf16x8*)(sW + (wave * 16 + l16) * 136 + ks * 32 + quad * 8);
#pragma unroll
        for (int j = 0; j < 2; j++)
          vn[j] = mfma16(a, *(const bf16x8*)(sST + (j * 16 + l16) * 136 + ks * 32 + quad * 8), vn[j]);
      }
#pragma unroll
      for (int j = 0; j < 2; j++) {
#pragma unroll
        for (int e = 0; e < 4; e++) vn[j][e] = uu[j][e] - vn[j][e];
        uint2 pk = make_uint2(pack2(vn[j][0], vn[j][1]), pack2(vn[j][2], vn[j][3]));
        *(uint2*)(sVN + (j * 16 + l16) * 72 + wave * 16 + quad * 4) = pk;
      }
    }
    __syncthreads();
    {
      f32x4 o[2];
      o[0] = zero4(); o[1] = zero4();
#pragma unroll
      for (int ks = 0; ks < 4; ks++) {
        bf16x8 a = *(const bf16x8*)(sQ + (wave * 16 + l16) * 136 + ks * 32 + quad * 8);
#pragma unroll
        for (int j = 0; j < 2; j++)
          o[j] = mfma16(a, *(const bf16x8*)(sST + (j * 16 + l16) * 136 + ks * 32 + quad * 8), o[j]);
      }
#pragma unroll
      for (int ks = 0; ks < 2; ks++) {
        bf16x8 a = *(const bf16x8*)(sQK + (wave * 16 + l16) * 72 + ks * 32 + quad * 8);
#pragma unroll
        for (int j = 0; j < 2; j++)
          o[j] = mfma16(a, *(const bf16x8*)(sVN + (j * 16 + l16) * 72 + ks * 32 + quad * 8), o[j]);
      }
#pragma unroll
      for (int j = 0; j < 2; j++)
#pragma unroll
        for (int e = 0; e < 4; e++)
          OD[(size_t)(r0 + wave * 16 + quad * 4 + e) * 512 + h * 128 + s * 32 + j * 16 + l16] = f2bf(o[j][e]);
    }
    {
      const float eg = __expf(glast);
#pragma unroll
      for (int i = 0; i < 2; i++)
#pragma unroll
        for (int j = 0; j < 2; j++) {
#pragma unroll
          for (int e = 0; e < 4; e++) S[i][j][e] *= eg;
#pragma unroll
          for (int ks = 0; ks < 2; ks++)
            S[i][j] = mfma16(*(const bf16x8*)(sKT + ((2 * wave + i) * 16 + l16) * 72 + (((ks * 4 + quad) ^ ((((2 * wave + i) * 16 + l16) >> 3) & 7)) << 3)),
                             *(const bf16x8*)(sVN + (j * 16 + l16) * 72 + ks * 32 + quad * 8), S[i][j]);
        }
    }
    __syncthreads();
  }
  if (!lat) {
    float* o = p.out + OUT_GDN + ((size_t)((b * 4 + l) * 2 + d) * 4 + h) * 16384;
#pragma unroll
    for (int i = 0; i < 2; i++)
#pragma unroll
      for (int j = 0; j < 2; j++)
#pragma unroll
        for (int e = 0; e < 4; e++) o[((2 * wave + i) * 16 + quad * 4 + e) * 128 + s * 32 + j * 16 + l16] = S[i][j][e];
  }
}

DEV void phase_gdn_post(const Params& p, int l, int dry) {
  const int vbid = blockIdx.x * 2 + vhalf(), vnb = gridDim.x * 2;
  const int tid = opaque_tid(), lane = tid & 63, wave = tid >> 6;
  bf16* O0 = (bf16*)(p.ws + OFF_CQ);
  const bf16* O1 = (const bf16*)(p.ws + OFF_CK);
  const bf16* CZ = (const bf16*)(p.ws + OFF_CZ);
  const float* nw = p.in[20] + l * 128 + (lane & 15) * 8;
  const float4 w0 = *(const float4*)nw, w1 = *(const float4*)(nw + 4);
  const int gw = vbid * 4 + wave, nwt = vnb * 4;
  typedef unsigned int u32x4 __attribute__((ext_vector_type(4)));
  u32x4 pa = {0u, 0u, 0u, 0u}, pb2 = pa, pz = pa;
  if (gw < M_TOT) {
    const size_t off0 = ((size_t)gw * 4 + (lane >> 4)) * 128 + (lane & 15) * 8;
    pa = *(const u32x4*)(O0 + off0); pb2 = *(const u32x4*)(O1 + off0); pz = *(const u32x4*)(CZ + off0);
  }
  for (int t4 = gw; t4 < M_TOT; t4 += nwt) {
    const size_t off = ((size_t)t4 * 4 + (lane >> 4)) * 128 + (lane & 15) * 8;
    U8 a, b2, z;
    a.w[0] = pa[0]; a.w[1] = pa[1]; a.w[2] = pa[2]; a.w[3] = pa[3];
    b2.w[0] = pb2[0]; b2.w[1] = pb2[1]; b2.w[2] = pb2[2]; b2.w[3] = pb2[3];
    z.w[0] = pz[0]; z.w[1] = pz[1]; z.w[2] = pz[2]; z.w[3] = pz[3];
    {
      const int tn = (t4 + nwt < M_TOT) ? t4 + nwt : t4;
      const size_t offn = ((size_t)tn * 4 + (lane >> 4)) * 128 + (lane & 15) * 8;
      pa = *(const u32x4*)(O0 + offn); pb2 = *(const u32x4*)(O1 + offn); pz = *(const u32x4*)(CZ + offn);
    }
    float x[8];
    float ss = 0.f;
#pragma unroll
    for (int i = 0; i < 4; i++) {
      x[2 * i] = lo2f(a.w[i]) + lo2f(b2.w[i]);
      x[2 * i + 1] = hi2f(a.w[i]) + hi2f(b2.w[i]);
      ss += x[2 * i] * x[2 * i] + x[2 * i + 1] * x[2 * i + 1];
    }
    ss += __shfl_xor(ss, 1); ss += __shfl_xor(ss, 2); ss += __shfl_xor(ss, 4); ss += __shfl_xor(ss, 8);
    const float rstd = rsqrtf(ss * (1.f / 128.f) + EPS);
    U8 o;
    o.w[0] = pack2(x[0] * rstd * w0.x * lo2f(z.w[0]), x[1] * rstd * w0.y * hi2f(z.w[0]));
    o.w[1] = pack2(x[2] * rstd * w0.z * lo2f(z.w[1]), x[3] * rstd * w0.w * hi2f(z.w[1]));
    o.w[2] = pack2(x[4] * rstd * w1.x * lo2f(z.w[2]), x[5] * rstd * w1.y * hi2f(z.w[2]));
    o.w[3] = pack2(x[6] * rstd * w1.z * lo2f(z.w[3]), x[7] * rstd * w1.w * hi2f(z.w[3]));
    if (!dry) *(uint4*)(O0 + off) = o.u;
  }
}

struct AttnState {
  f32x4 O[2][8];
  f32x4 Os[2];
  float mx[2];
};
DEV void attn_qk(AttnState& st, const char* sK, const bf16x8 (&qf)[2][2], const int (&koff)[2], bf16x8 (&pb)[2][2]) {
  f32x4 S[4][2];
#pragma unroll
  for (int kti = 0; kti < 4; kti++) { S[kti][0] = zero4(); S[kti][1] = zero4(); }
#pragma unroll
  for (int ks = 0; ks < 2; ks++)
#pragma unroll
    for (int kti = 0; kti < 4; kti++) {
      bf16x8 a = *(const bf16x8*)(sK + koff[ks] + kti * 2048);
      S[kti][0] = mfma16(a, qf[0][ks], S[kti][0]);
      S[kti][1] = mfma16(a, qf[1][ks], S[kti][1]);
    }
#pragma unroll
  for (int qt = 0; qt < 2; qt++) {
    float tm = S[0][qt][0];
#pragma unroll
    for (int kti = 0; kti < 4; kti++)
#pragma unroll
      for (int e = 0; e < 4; e++) tm = fmaxf(tm, S[kti][qt][e]);
    if (__any(tm > st.mx[qt] + 8.f)) {
      tm = fmaxf(tm, __shfl_xor(tm, 16));
      tm = fmaxf(tm, __shfl_xor(tm, 32));
      const float mnew = fmaxf(st.mx[qt], tm);
      const float alpha = ex2(st.mx[qt] - mnew);
      st.mx[qt] = mnew;
#pragma unroll
      for (int dt = 0; dt < 8; dt++)
#pragma unroll
        for (int e = 0; e < 4; e++) st.O[qt][dt][e] *= alpha;
#pragma unroll
      for (int e = 0; e < 4; e++) st.Os[qt][e] *= alpha;
    }
    const float mref = st.mx[qt];
#pragma unroll
    for (int kti = 0; kti < 4; kti++)
#pragma unroll
      for (int e = 0; e < 4; e++) S[kti][qt][e] = ex2(S[kti][qt][e] - mref);
#pragma unroll
    for (int cch = 0; cch < 2; cch++) {
      U8 pk;
      pk.w[0] = pack2(S[2 * cch][qt][0], S[2 * cch][qt][1]);
      pk.w[1] = pack2(S[2 * cch][qt][2], S[2 * cch][qt][3]);
      pk.w[2] = pack2(S[2 * cch + 1][qt][0], S[2 * cch + 1][qt][1]);
      pk.w[3] = pack2(S[2 * cch + 1][qt][2], S[2 * cch + 1][qt][3]);
      pb[qt][cch] = pk.v;
    }
  }
  __builtin_amdgcn_sched_barrier(0);
}
DEV void attn_pv(AttnState& st, const char* sV, const bf16x8 (&pb)[2][2], const int (&voff)[2]) {
  U8 ones;
  ones.w[0] = 0x3F803F80u; ones.w[1] = 0x3F803F80u; ones.w[2] = 0x3F803F80u; ones.w[3] = 0x3F803F80u;
#pragma unroll
  for (int cch = 0; cch < 2; cch++) {
    st.Os[0] = mfma16(ones.v, pb[0][cch], st.Os[0]);
    st.Os[1] = mfma16(ones.v, pb[1][cch], st.Os[1]);
#pragma unroll
    for (int dt = 0; dt < 8; dt++) {
      const bf16x8 a = *(const bf16x8*)(sV + dt * 2048 + voff[cch]);
      st.O[0][dt] = mfma16(a, pb[0][cch], st.O[0][dt]);
      st.O[1][dt] = mfma16(a, pb[1][cch], st.O[1][dt]);
    }
  }
  __builtin_amdgcn_sched_barrier(0);
}

DEV void attn_item8(const Params& p, int l_in, int item, const Lds4& L, int dry) {
  int l = l_in;
  asm volatile("" : "+s"(l));
  const int tid = raw_tid(), lane = tid & 63, l16 = lane & 15, quad = lane >> 4;
  const int wave = __builtin_amdgcn_readfirstlane(tid >> 6);
  const int g = wave >> 1, m = wave & 1;
  bool lat; int b, h, qb;
  if (item < 512) { lat = true; b = item >> 7; h = (item >> 5) & 3; qb = item & 31; }
  else { int it = item - 512; lat = false; b = it >> 3; h = (it >> 1) & 3; qb = it & 1; }
  const int rowbase = lat ? M_CTX + b * 4096 + qb * 128 : b * 256 + qb * 128;
  const int nkt = lat ? 68 : 4;
  bf16* QA = (bf16*)(p.ws + OFF_QA);
  const bf16* KA = (const bf16*)(p.ws + OFF_KA);
  const bf16* KC = (const bf16*)(p.ws + OFF_KC);
  const bf16* VT = lat ? (const bf16*)(p.ws + OFF_VTL) + (size_t)(b * 4 + h) * 128 * 4352
                       : (const bf16*)(p.ws + OFF_VTC) + (size_t)(b * 4 + h) * 128 * 256;
  const int vts = lat ? 4352 : 256;
  float c08 = 0.8f;
  asm volatile("" : "+v"(c08));
  const float lam_init = c08 - 0.6f * expf(-0.3f * (float)l);
  float lam;
  {
    const float* lv = p.in[13] + l * 256;
    float a = lv[lane] * lv[64 + lane], c2 = lv[128 + lane] * lv[192 + lane];
#pragma unroll
    for (int o = 32; o >= 1; o >>= 1) { a += __shfl_xor(a, o); c2 += __shfl_xor(c2, o); }
    lam = expf(a) - expf(c2) + lam_init;
  }
  bf16x8 qf[2][2];
#pragma unroll
  for (int qt = 0; qt < 2; qt++)
#pragma unroll
    for (int ks = 0; ks < 2; ks++)
      qf[qt][ks] = *(const bf16x8*)(QA + (size_t)(rowbase + g * 32 + qt * 16 + l16) * 512 + h * 128 + m * 64 + ks * 32 + quad * 8);
  AttnState st;
#pragma unroll
  for (int qt = 0; qt < 2; qt++) {
    st.mx[qt] = -1e30f; st.Os[qt] = zero4();
#pragma unroll
    for (int dt = 0; dt < 8; dt++) st.O[qt][dt] = zero4();
  }
  unsigned ko[2], vo[2];
#pragma unroll
  for (int i = 0; i < 2; i++) {
    int r, c;
    stage_rc2(wave * 1024 + i * 8192 + lane * 16, r, c);
    ko[i] = (unsigned)((r & 63) * 512 + (r >> 6) * 64 + c) * 2u;
    {
      const int vb = wave * 1024 + i * 8192 + lane * 16, vr = vb >> 7, vg = (vb >> 4) & 7;
      vo[i] = (unsigned)(vr * vts + ((vg ^ ((vr >> 1) & 7)) << 3)) * 2u;
    }
  }
  int koff[2];
#pragma unroll
  for (int ks = 0; ks < 2; ks++) koff[ks] = lds_byte2(l16, ks * 32 + quad * 8) + m * 8192;
  int voff[2];
#pragma unroll
  for (int cch = 0; cch < 2; cch++) voff[cch] = l16 * 128 + (((cch * 4 + quad) ^ ((l16 >> 1) & 7)) << 4);
  auto kbase = [&](int kt) -> const bf16* {
    if (lat) return (kt < 64) ? KA + (size_t)(M_CTX + b * 4096 + kt * 64) * 512 + h * 128
                              : KC + (size_t)(b * 256 + (kt - 64) * 64) * 512 + h * 128;
    return KA + (size_t)(b * 256 + kt * 64) * 512 + h * 128;
  };
  auto stage = [&](char* sb, int kt) {
    const bf16* kp = kbase(kt);
    const bf16* vp = VT + kt * 64;
#pragma unroll
    for (int i = 0; i < 2; i++) {
      __builtin_amdgcn_global_load_lds((const unsigned*)((const char*)kp + ko[i]), (unsigned*)(sb + wave * 1024 + i * 8192), 16, 0, 0);
      __builtin_amdgcn_global_load_lds((const unsigned*)((const char*)vp + vo[i]), (unsigned*)(sb + 16384 + wave * 1024 + i * 8192), 16, 0, 0);
    }
    __builtin_amdgcn_sched_barrier(0);
  };
  auto stage_c = [&](char* sb, int kt) { stage(sb, kt < nkt ? kt : nkt - 1); };
  const bool lagB = wave >= 4;
  bf16x8 pb[2][2];
#pragma unroll
  for (int i = 0; i < 2; i++)
#pragma unroll
    for (int j = 0; j < 2; j++) { U8 z; z.u = make_uint4(0u, 0u, 0u, 0u); pb[i][j] = z.v; }
  __syncthreads();
  stage_c(L.a0, 0);
  stage_c(L.b0, 1);
#define ATTN_STEP(OBJ_CUR, OBJ_PREV, OBJ_NEXT2, KT)                                   \
  asm volatile("s_waitcnt vmcnt(4)" ::: "memory");                                     \
  __builtin_amdgcn_s_barrier();                                                        \
  stage_c(OBJ_NEXT2, (KT) + 2);                                                        \
  if (lagB && (KT) > 0) attn_pv(st, (OBJ_PREV) + 16384, pb, voff);             \
  attn_qk(st, OBJ_CUR, qf, koff, pb);                                                  \
  if (!lagB) attn_pv(st, (OBJ_CUR) + 16384, pb, voff);
  for (int kt = 0; kt < nkt; kt += 4) {
    ATTN_STEP(L.a0, L.b1, L.a1, kt)
    ATTN_STEP(L.b0, L.a0, L.b1, kt + 1)
    ATTN_STEP(L.a1, L.b0, L.a0, kt + 2)
    ATTN_STEP(L.b1, L.a1, L.b0, kt + 3)
  }
#undef ATTN_STEP
  if (lagB) attn_pv(st, L.b1 + 16384, pb, voff);
  WAIT_V0();
  __syncthreads();
  float* X = (float*)((g < 2) ? L.a0 : L.a1) - (g >> 1) * 64 * 132;
#pragma unroll
  for (int qt = 0; qt < 2; qt++) {
    const float inv = (m ? lam : 1.f) / st.Os[qt][0];
#pragma unroll
    for (int dt = 0; dt < 8; dt++)
#pragma unroll
      for (int e = 0; e < 4; e++) st.O[qt][dt][e] *= inv;
  }
  if (m == 1) {
#pragma unroll
    for (int qt = 0; qt < 2; qt++)
#pragma unroll
      for (int dt = 0; dt < 8; dt++)
        *(f32x4*)(X + (g * 32 + qt * 16 + l16) * 132 + dt * 16 + quad * 4) = st.O[qt][dt];
  }
  __syncthreads();
  if (m == 0 && !dry) {
    int rowbase2 = rowbase;
    asm volatile("" : "+s"(rowbase2));
    const bf16* AZ = (const bf16*)(p.ws + OFF_AZ);
    const float* sw = p.in[14] + l * 128;
#pragma unroll
    for (int qt = 0; qt < 2; qt++) {
      float ss = 0.f;
#pragma unroll
      for (int dt = 0; dt < 8; dt++) {
        f32x4 x1 = *(const f32x4*)(X + (g * 32 + qt * 16 + l16) * 132 + dt * 16 + quad * 4);
#pragma unroll
        for (int e = 0; e < 4; e++) {
          float v = st.O[qt][dt][e] - x1[e];
          st.O[qt][dt][e] = v;
          ss += v * v;
        }
      }
      ss += __shfl_xor(ss, 16);
      ss += __shfl_xor(ss, 32);
      const float rstd = rsqrtf(ss * (1.f / 128.f) + EPS) * (1.f - lam_init);
      const size_t rowoff = (size_t)(rowbase2 + g * 32 + qt * 16 + l16) * 512 + h * 128;
#pragma unroll
      for (int dt = 0; dt < 8; dt++) {
        const int dv = dt * 16 + quad * 4;
        float4 w4 = *(const float4*)(sw + dv);
        uint2 z = *(const uint2*)(AZ + rowoff + dv);
        uint2 o2;
        o2.x = pack2(st.O[qt][dt][0] * rstd * w4.x * lo2f(z.x), st.O[qt][dt][1] * rstd * w4.y * hi2f(z.x));
        o2.y = pack2(st.O[qt][dt][2] * rstd * w4.z * lo2f(z.y), st.O[qt][dt][3] * rstd * w4.w * hi2f(z.y));
        *(uint2*)(QA + rowoff + dv) = o2;
      }
    }
  }
}

template <int NT>
DEV void merge_tile(const Params& p, int l, const Lds4& L, int mt, int ncol0) {
  const int tid = raw_tid(), lane = tid & 63;
  int l16 = lane & 15, quad = lane >> 4;
  const int wave = __builtin_amdgcn_readfirstlane(tid >> 6);
  const int wm = wave >> 2, wn = wave & 3;
  const bf16* H = (const bf16*)(p.ws + OFF_H);
  const bf16* WG = (const bf16*)wset(p, l) + (size_t)5888 * 1024;
  const bf16* WB = (const bf16*)(wset(p, l) + WSET_WBT);
  bf16* MG = (bf16*)(p.ws + OFF_U);
  uint32_t* gpl0 = (uint32_t*)(L.b0 + 16384);
  uint32_t* gpl1 = (uint32_t*)(L.b1 + 16384);
  f32x4 tot[8][NT];
  zero_acc<NT>(tot);
#pragma unroll 1
  for (int br = 0; br < 3; br++) {
    uint32_t gp[8][NT][2];
    {
      f32x4 acc[8][NT];
      zero_acc<NT>(acc);
      gemm_loop8<NT, true>(acc, H + (size_t)mt * 256 * 1024, 1024, WG + (size_t)(br * 1024 + ncol0) * 1024, 1024, 1024, L);
#pragma unroll
      for (int i = 0; i < 8; i++)
#pragma unroll
        for (int j = 0; j < NT; j++) {
          gp[i][j][0] = pack2(sigm(acc[i][j][0]), sigm(acc[i][j][1]));
          gp[i][j][1] = pack2(sigm(acc[i][j][2]), sigm(acc[i][j][3]));
        }
      if (NT == 2) {
#pragma unroll
        for (int i = 4; i < 8; i++)
#pragma unroll
          for (int j = 0; j < NT; j++) {
            uint32_t* gpl = (i < 6) ? gpl0 : gpl1;
            gpl[(((i - 4) & 1) * 4 + j * 2 + 0) * 512 + tid] = gp[i][j][0];
            gpl[(((i - 4) & 1) * 4 + j * 2 + 1) * 512 + tid] = gp[i][j][1];
          }
      }
    }
    {
      const bf16* A = (const bf16*)(p.ws + (br == 0 ? OFF_QA : (br == 1 ? OFF_BV : OFF_CQ)));
      f32x4 acc[8][NT];
      zero_acc<NT>(acc);
      gemm_loop8<NT, true>(acc, A + (size_t)mt * 256 * 512, 512, WB + (size_t)(br * 1024 + ncol0) * 512, 512, 512, L);
      if (NT == 2) {
#pragma unroll
        for (int i = 4; i < 8; i++)
#pragma unroll
          for (int j = 0; j < NT; j++) {
            const uint32_t* gpl = (i < 6) ? gpl0 : gpl1;
            gp[i][j][0] = gpl[(((i - 4) & 1) * 4 + j * 2 + 0) * 512 + tid];
            gp[i][j][1] = gpl[(((i - 4) & 1) * 4 + j * 2 + 1) * 512 + tid];
          }
      }
#pragma unroll
      for (int i = 0; i < 8; i++)
#pragma unroll
        for (int j = 0; j < NT; j++) {
          tot[i][j][0] += lo2f(gp[i][j][0]) * acc[i][j][0];
          tot[i][j][1] += hi2f(gp[i][j][0]) * acc[i][j][1];
          tot[i][j][2] += lo2f(gp[i][j][1]) * acc[i][j][2];
          tot[i][j][3] += hi2f(gp[i][j][1]) * acc[i][j][3];
        }
    }
  }
  asm volatile("" : "+v"(l16), "+v"(quad));
  const int row0 = mt * 256 + wm * 128, col0 = ncol0 + wn * NT * 16;
#pragma unroll
  for (int i = 0; i < 8; i++) {
    bf16* d = MG + (size_t)(row0 + i * 16 + l16) * 1024 + col0 + quad * 4;
#pragma unroll
    for (int j = 0; j < NT; j++) *(uint2*)(d + j * 16) = make_uint2(pack2(tot[i][j][0], tot[i][j][1]), pack2(tot[i][j][2], tot[i][j][3]));
  }
}
DEV void phase_merge(const Params& p, int l, const Lds4& L) {
  const int vbx = xcd_compact_bid();
  for (int tile = vbx; tile < 512; tile += gridDim.x) merge_tile<2>(p, l, L, tile >> 3, (tile & 7) * 128);
  for (int t = vbx; t < 256; t += gridDim.x) merge_tile<1>(p, l, L, 64 + (t >> 4), (t & 15) * 64);
}

template <int NT>
DEV void out_tile(const Params& p, int l, const Lds4& L, int mt, int ncol0) {
  const int tid = raw_tid(), lane = tid & 63;
  int l16 = lane & 15, quad = lane >> 4;
  const int wave = __builtin_amdgcn_readfirstlane(tid >> 6);
  const int wm = wave >> 2, wn = wave & 3;
  const bf16* MG = (const bf16*)(p.ws + OFF_U);
  const bf16* WO = (const bf16*)(wset(p, l) + WSET_WOT);
  const float* mod = (const float*)(p.ws + OFF_MOD);
  f32x4 acc[8][NT];
  zero_acc<NT>(acc);
  gemm_loop8<NT, true>(acc, MG + (size_t)mt * 256 * 1024, 1024, WO + (size_t)ncol0 * 1024, 1024, 1024, L);
  asm volatile("" : "+v"(l16), "+v"(quad));
  const int row0 = mt * 256 + wm * 128, col0 = ncol0 + wn * NT * 16;
  const int ci = row0 < M_CTX ? 0 : 1 + ((row0 - M_CTX) >> 12);
  const float* gate = mod + (l * 5 + ci) * 3072 + 2048 + col0 + quad * 4;
  float4 gv[NT];
#pragma unroll
  for (int j = 0; j < NT; j++) gv[j] = *(const float4*)(gate + j * 16);
#pragma unroll
  for (int i = 0; i < 8; i++) {
    const int row = row0 + i * 16 + l16;
    const float* xs;
    if (l == 0) xs = row < M_CTX ? p.in[0] + (size_t)row * 1024 : p.in[1] + (size_t)(row - M_CTX) * 1024;
    else xs = p.out + (size_t)row * 1024;
    float* xo = p.out + (size_t)row * 1024 + col0 + quad * 4;
    xs += col0 + quad * 4;
#pragma unroll
    for (int j = 0; j < NT; j++) {
      const float4 xv = *(const float4*)(xs + j * 16);
      float4 o;
      o.x = xv.x + gv[j].x * acc[i][j][0]; o.y = xv.y + gv[j].y * acc[i][j][1];
      o.z = xv.z + gv[j].z * acc[i][j][2]; o.w = xv.w + gv[j].w * acc[i][j][3];
      *(float4*)(xo + j * 16) = o;
    }
  }
}
DEV void phase_out(const Params& p, int l, const Lds4& L) {
  const int vbx = xcd_compact_bid();
  for (int tile = vbx; tile < 512; tile += gridDim.x) out_tile<2>(p, l, L, tile >> 3, (tile & 7) * 128);
  for (int t = vbx; t < 256; t += gridDim.x) out_tile<1>(p, l, L, 64 + (t >> 4), (t & 15) * 64);
}


#define XB_TMO      128
#define XB_XCNT(j)  (256  + 64 * (j))
#define XB_XSUB(j)  (1280 + 64 * (j))
#define XB_XGEN(j)  (2304 + 64 * (j))
#define XB_TOP      3328
#define XB_TOPGEN   3392
#define XCD_BAR_WORDS 3456
#define XB_SPIN_CAP (1u << 18)
#define LAS __attribute__((address_space(3)))
DEV unsigned xb_ld(unsigned* p) { return __hip_atomic_load(p, __ATOMIC_RELAXED, __HIP_MEMORY_SCOPE_AGENT); }
DEV unsigned xb_add(unsigned* p, unsigned v) { return __hip_atomic_fetch_add(p, v, __ATOMIC_RELAXED, __HIP_MEMORY_SCOPE_AGENT); }
DEV unsigned xb_xcc_id() { return (unsigned)__builtin_amdgcn_s_getreg((3 << 11) | 20) & 0xFu; }
#define XB_SPIN(cond, bar) do { unsigned _sp = 0; while (cond) { __builtin_amdgcn_s_sleep(1); \
    if ((++_sp & 255u) == 0u) { if (xb_ld(&(bar)[XB_TMO])) break; if (_sp > XB_SPIN_CAP) { atomicAdd(&(bar)[XB_TMO], 1u); break; } } } } while (0)
struct XcdBarrier { unsigned* bar; unsigned x; volatile LAS unsigned* st; };
DEV XcdBarrier xcd_barrier_post(unsigned* bar, volatile LAS unsigned* st) {
  XcdBarrier b; b.bar = bar; b.x = xb_xcc_id(); b.st = st;
  if (threadIdx.x == 0) (void)xb_add(&bar[XB_XCNT(b.x)], 1u);
  return b;
}
DEV void xcd_barrier_complete(unsigned* bar, unsigned x, unsigned& nloc, unsigned& nx) {
  const unsigned G = gridDim.x * gridDim.y * gridDim.z;
  unsigned sum, cnt, mine, sp = 0u;
  for (;;) {
    sum = 0u; cnt = 0u; mine = 0u;
#pragma unroll
    for (unsigned j = 0; j < 16; ++j) { const unsigned c = xb_ld(&bar[XB_XCNT(j)]); sum += c; cnt += (c > 0u) ? 1u : 0u; mine = (j == x) ? c : mine; }
    if (sum == G) break;
    __builtin_amdgcn_s_sleep(1);
    if ((++sp & 255u) == 0u) { if (xb_ld(&bar[XB_TMO])) break; if (sp > XB_SPIN_CAP) { atomicAdd(&bar[XB_TMO], 1u); break; } }
  }
  nloc = mine > 0u ? mine : 1u; nx = cnt > 0u ? cnt : 1u;
}
DEV void xcd_barrier(const XcdBarrier& b) {
  asm volatile("s_waitcnt vmcnt(0)" ::: "memory");
  __syncthreads();
  if (threadIdx.x == 0) {
    unsigned* bar = b.bar;
    __builtin_amdgcn_s_waitcnt(0);
    unsigned nloc = b.st[0], nx = b.st[1];
    if (nloc == 0u) { xcd_barrier_complete(bar, b.x, nloc, nx); b.st[0] = nloc; b.st[1] = nx; }
    const unsigned old = xb_add(&bar[XB_XSUB(b.x)], 1u);
    const unsigned gen = old / nloc;
    if (old + 1u == (gen + 1u) * nloc) {
      __builtin_amdgcn_fence(__ATOMIC_RELEASE, "agent");
      asm volatile("s_waitcnt vmcnt(0)" ::: "memory");
      const unsigned og = xb_add(&bar[XB_TOP], 1u);
      const unsigned tg = og / nx;
      if (og + 1u == (tg + 1u) * nx) xb_add(&bar[XB_TOPGEN], 1u);
      else XB_SPIN(xb_ld(&bar[XB_TOPGEN]) == tg, bar);
      __builtin_amdgcn_fence(__ATOMIC_ACQUIRE, "agent");
      xb_add(&bar[XB_XGEN(b.x)], 1u);
      asm volatile("s_waitcnt vmcnt(0)" ::: "memory");
    } else {
      XB_SPIN(xb_ld(&bar[XB_XGEN(b.x)]) == gen, bar);
      __builtin_amdgcn_fence(__ATOMIC_ACQUIRE, "agent");
      asm volatile("s_waitcnt vmcnt(0)" ::: "memory");
    }
  }
  __syncthreads();
}

#define DUP_PROJ 0
#define DUP_MERGE 0
#define DUP_CHAIN 0
#define DUP_PREP 0
#define DUP_SYNC 0
#define DUP_NORM 0
#define DUP_POST 0
#if DUP_SYNC
#define GSYNC() do { xcd_barrier(xb); xcd_barrier(xb); } while (0)
#else
#define GSYNC() xcd_barrier(xb)
#endif
#define DUP_ATTN 0
__global__ void __launch_bounds__(512, 2) fwd_megakernel(Params p) {
  cg::grid_group grid = cg::this_grid();
  __shared__ __attribute__((aligned(1024))) unsigned char smA0[40960];
  __shared__ __attribute__((aligned(1024))) unsigned char smB0[36864];
  __shared__ __attribute__((aligned(1024))) unsigned char smA1[40960];
  __shared__ __attribute__((aligned(1024))) unsigned char smB1[36864];
  __shared__ int s_item;
  __shared__ uint4 xb_words;
  const int hv = vhalf();
  bf16* sm = (bf16*)(hv ? smA1 : smA0);
  bf16* smB = (bf16*)(hv ? smB1 : smB0);
  Lds4 L4;
  L4.a0 = (char*)smA0; L4.b0 = (char*)smB0; L4.a1 = (char*)smA1; L4.b1 = (char*)smB1;
  float* smf = (float*)sm;
  const int vbid = blockIdx.x * 2 + hv, vnb = gridDim.x * 2;
  const int vbidc = xcd_compact_bid() * 2 + hv;
  if (threadIdx.x == 0) xb_words = make_uint4(0u, 0u, 0u, 0u);
  __syncthreads();
  XcdBarrier xb = xcd_barrier_post((unsigned*)(p.ws + OFF_BAR), (volatile LAS unsigned*)&xb_words);
  phase_mod(p, smf);
  grid.sync();
#pragma unroll 1
  for (int l0 = 0; l0 < 4; l0++) {
    int l = l0;
    asm volatile("" : "+s"(l));
    {
      int reps = 1 + DUP_NORM;
      asm volatile("" : "+s"(reps));
#pragma unroll 1
      for (int r = 0; r < reps; r++) { phase_norm(p, l); if (l == 0) phase_cvt(p, l, smf); }
    }
    GSYNC();
    {
      int reps = 1 + DUP_PROJ;
      asm volatile("" : "+s"(reps));
#pragma unroll 1
      for (int r = 0; r < reps; r++) phase_proj(p, l, L4);
    }
    GSYNC();
    for (;;) {
      __syncthreads();
      if (raw_tid() == 0) s_item = atomicAdd((int*)(p.ws + OFF_BAR + 14336) + 8 + l, 1);
      __syncthreads();
      const int q = __builtin_amdgcn_readfirstlane(s_item);
      if (q >= 1280) break;
      const int it = q * 2 + hv;
      if (it < 1280) gdn_prep_item(p, l, it, sm, smB);
      else ret_prep_item(p, l, it - 1280, sm);
    }
    GSYNC();
    {
      int reps = 1 + DUP_CHAIN;
      asm volatile("" : "+s"(reps));
#pragma unroll 1
      for (int r = 0; r < reps; r++)
        for (int it = vbidc; it < 640; it += vnb) gdn_chain_item(p, l, it, sm, smB);
    }
    for (int it = vbidc + 640; it < 1280; it += vnb) ret_scan_item(p, l, it - 640);
#if DUP_ATTN
    {
      int reps = 2;
      asm volatile("" : "+s"(reps));
#pragma unroll 1
      for (int r = 0; r < reps; r++) {
        const int dry = (r + 1 < reps) ? 1 : 0;
        for (;;) {
          __syncthreads();
          if (raw_tid() == 0) s_item = atomicAdd((int*)(p.ws + OFF_BAR + 14336) + l * 2 + dry, 1);
          __syncthreads();
          const int it = __builtin_amdgcn_readfirstlane(s_item);
          if (it >= 640) break;
          attn_item8(p, l, it, L4, dry);
        }
      }
    }
#else
    for (;;) {
      __syncthreads();
      if (raw_tid() == 0) s_item = atomicAdd((int*)(p.ws + OFF_BAR + 14336) + l, 1);
      __syncthreads();
      const int it = __builtin_amdgcn_readfirstlane(s_item);
      if (it >= 640) break;
      attn_item8(p, l, it, L4, 0);
    }
#endif
    if (l < 3) {
      for (;;) {
        __syncthreads();
        if (raw_tid() == 0) s_item = atomicAdd((int*)(p.ws + OFF_BAR + 14336) + 12 + l, 1);
        __syncthreads();
        const int q = __builtin_amdgcn_readfirstlane(s_item);
        if (q >= 1440) break;
        const CvtT ct = cvt_params(p, l + 1, q * 2 + hv);
        float cv[16];
        cvt_load(ct, cv, opaque_tid());
        cvt_store(ct, cv, smf, opaque_tid());
      }
    }
    GSYNC();
    {
      int reps = 1 + DUP_POST;
      asm volatile("" : "+s"(reps));
#pragma unroll 1
      for (int r = 0; r < reps; r++) {
        const int dry = (r + 1 < reps) ? 1 : 0;
        for (int it = vbid; it < 1280; it += vnb) ret_post_item(p, l, it, sm, smB, dry);
        phase_gdn_post(p, l, dry);
      }
    }
    GSYNC();
    {
      int reps = 1 + DUP_MERGE;
      asm volatile("" : "+s"(reps));
#pragma unroll 1
      for (int r = 0; r < reps; r++) phase_merge(p, l, L4);
    }
    GSYNC();
    phase_out(p, l, L4);
    GSYNC();
  }
}

extern "C" void kernel_launch(void* const* d_in, const int* in_sizes, int n_in, void* d_out, int out_size, void* d_ws,
                              size_t ws_size, hipStream_t stream) {
  static int grid_blocks = 0;
  if (!grid_blocks) {
    int dev = 0, cus = 0, per_cu = 0;
    (void)hipGetDevice(&dev);
    (void)hipDeviceGetAttribute(&cus, hipDeviceAttributeMultiprocessorCount, dev);
    (void)hipOccupancyMaxActiveBlocksPerMultiprocessor(&per_cu, fwd_megakernel, 512, 0);
    if (per_cu > 1) per_cu = 1;
    if (per_cu < 1) per_cu = 1;
    grid_blocks = cus * per_cu;
  }
  if (ws_size < WS_NEED) {
    fprintf(stderr, "workspace too small: %zu < %zu\n", ws_size, (size_t)WS_NEED);
    return;
  }
  Params p{};
  for (int i = 0; i < 23; i++) p.in[i] = (const float*)d_in[i];
  p.out = (float*)d_out;
  p.ws = (unsigned char*)d_ws;
  (void)hipMemsetAsync((unsigned char*)d_ws + OFF_BAR, 0, 16384, stream);
  void* args[] = {&p};
  hipError_t e = hipLaunchCooperativeKernel((const void*)fwd_megakernel, dim3(grid_blocks), dim3(512), args, 0, stream);
  if (e != hipSuccess) fprintf(stderr, "cooperative launch failed: %s (grid %d)\n", hipGetErrorString(e), grid_blocks);
}
```
